# Optimizing an MI355X kernel written in HIP

```python
import math
import jax
import jax.numpy as jnp
from jax import lax
import numpy as np

D_MODEL = 2048
BATCH = 16
SEQ = 2048
DEPTH = 2

MEM_LEN = 256
GRID_W = 64
Q_BLOCK = 128
NORM_EPS = 1e-6
F32 = jnp.float32

HY_WIDTH = D_MODEL // 2
HY_EMB = 33
HY_BANDS = (HY_EMB - 1) // 2
HY_FILT = 64
HY_SHORT = 3
HY_TARGET = 1e-2
HY_FAST_PCT = 0.3
HY_SLOW_PCT = 1.5
DF_WIDTH = D_MODEL - HY_WIDTH
DF_HEADS = 8
DF_HEAD_DIM = DF_WIDTH // (2 * DF_HEADS)
DF_V_DIM = 2 * DF_HEAD_DIM
DF_QK_WIDTH = DF_HEADS * 2 * DF_HEAD_DIM
EVEN_IN = 3 * HY_WIDTH + 2 * DF_QK_WIDTH + DF_HEADS * DF_V_DIM

HG_WIDTH = D_MODEL // 2
HG_HEADS = 8
HG_DK = HG_WIDTH // HG_HEADS
HG_DV = HG_WIDTH // HG_HEADS
HG_CHUNK = 64
GQ_WIDTH = D_MODEL - HG_WIDTH
GQ_HEADS = 8
GQ_KV_HEADS = 2
GQ_HEAD_DIM = GQ_WIDTH // GQ_HEADS
GQ_GROUP = GQ_HEADS // GQ_KV_HEADS
GQ_KV_WIDTH = GQ_KV_HEADS * GQ_HEAD_DIM
ROPE_THETA = 10000.0
ODD_IN = 5 * HG_WIDTH + GQ_WIDTH + 2 * GQ_KV_WIDTH

CA_HEADS = 4
CA_HEAD_DIM = 128
CA_WIDTH = CA_HEADS * CA_HEAD_DIM
FFN_HIDDEN = 4 * D_MODEL

kernel_name = 'hybrid_hyena_diffattn_hgrn2_axialgqa'


def rms_norm(x, g):
    xf = x.astype(F32)
    y = xf * lax.rsqrt(jnp.mean(xf * xf, axis=-1, keepdims=True) + NORM_EPS)
    return (y * g.astype(F32)).astype(x.dtype)


def alibi_slopes(n_heads):
    return jnp.asarray(np.array([2.0 ** (-8.0 * (h + 1) / n_heads) for h in range(n_heads)], dtype=np.float32))


def sweep_query_blocks(block_fn, q):
    *lead, L, d = q.shape
    nb = L // Q_BLOCK
    qb = jnp.moveaxis(q.reshape(tuple(lead) + (nb, Q_BLOCK, d)), -3, 0)
    starts = jnp.arange(nb, dtype=jnp.int32) * Q_BLOCK
    out = lax.map(lambda a: block_fn(a[0], a[1]), (qb, starts))
    out = jnp.moveaxis(out, 0, -3)
    return out.reshape(out.shape[:-3] + (L, out.shape[-1]))


def short_conv(u, w, b):
    L = u.shape[1]
    p = HY_SHORT // 2
    up = jnp.pad(u, ((0, 0), (p, p), (0, 0)))
    y = sum(up[:, j:j + L] * w[j] for j in range(HY_SHORT))
    return y + b


def hyena_filters(L, w1, b1, w2, b2, w3, b3, w4, sin_freq):
    t = jnp.linspace(0.0, 1.0, L, dtype=F32)[:, None]
    w = (2.0 * math.pi / L) * jnp.arange(L, dtype=F32)[:, None]
    f = jnp.linspace(1e-4, HY_BANDS - 1, HY_BANDS, dtype=F32)[None, :]
    z = jnp.concatenate([t, jnp.cos(f * w), -jnp.sin(f * w)], axis=-1)
    freq = sin_freq.astype(F32)
    h = jnp.sin(freq * (z @ w1.astype(F32) + b1.astype(F32)))
    h = jnp.sin(freq * (h @ w2.astype(F32) + b2.astype(F32)))
    h = jnp.sin(freq * (h @ w3.astype(F32) + b3.astype(F32)))
    h = h @ w4.astype(F32)
    max_decay = math.log(HY_TARGET) / HY_FAST_PCT
    min_decay = math.log(HY_TARGET) / HY_SLOW_PCT
    deltas = jnp.linspace(min_decay, max_decay, HY_WIDTH, dtype=F32)
    window = jnp.exp(-t * jnp.abs(deltas)[None, :])
    h_fwd = h[:, :HY_WIDTH] * window
    h_bwd = h[:, HY_WIDTH:] * window
    return jnp.concatenate([h_fwd, jnp.zeros((1, HY_WIDTH), F32), h_bwd[:0:-1]], axis=0)


def two_sided_fft_conv(v, k_circ, bias):
    L = v.shape[1]
    V = jnp.fft.rfft(v, n=2 * L, axis=1)
    K = jnp.fft.rfft(k_circ, n=2 * L, axis=0)
    y = jnp.fft.irfft(V * K[None], n=2 * L, axis=1)[:, :L]
    return y + v * bias.astype(F32)


def hyena_mixer(u, conv_w, conv_b, w1, b1, w2, b2, w3, b3, w4, sin_freq, bias):
    L = u.shape[1]
    uc = short_conv(u, conv_w, conv_b)
    x1, x2, v = jnp.split(uc, 3, axis=-1)
    k_circ = hyena_filters(L, w1, b1, w2, b2, w3, b3, w4, sin_freq)
    z = two_sided_fft_conv((v * x2).astype(F32), k_circ, bias)
    return (z * x1.astype(F32)).astype(u.dtype)


def diff_attention(q, k, v, lam, slopes):
    L = q.shape[-2]
    scale = DF_HEAD_DIM ** -0.5
    pos_k = jnp.arange(L, dtype=jnp.int32)

    def block(qb, q0):
        s = jnp.einsum('bhjqd,bhjkd->bhjqk', qb, k).astype(F32) * scale
        pos_q = q0 + jnp.arange(Q_BLOCK, dtype=jnp.int32)
        dist = jnp.abs(pos_q[:, None] - pos_k[None, :]).astype(F32)
        p = jax.nn.softmax(s - slopes[:, None, None, None] * dist, axis=-1)
        a = p[:, :, 0] - lam * p[:, :, 1]
        return jnp.einsum('bhqk,bhkv->bhqv', a.astype(v.dtype), v)

    return sweep_query_blocks(block, q)


def even_mixer(h, layer, w_in, w_out, conv_w, conv_b, fw1, fb1, fw2, fb2, fw3, fb3, fw4, sin_freq,
               hy_bias, q_g, k_g, lam_q1, lam_k1, lam_q2, lam_k2, subln_g):
    B, L, _ = h.shape
    proj = h @ w_in
    u_a, q_b, k_b, v_b = jnp.split(
        proj, [3 * HY_WIDTH, 3 * HY_WIDTH + DF_QK_WIDTH, 3 * HY_WIDTH + 2 * DF_QK_WIDTH], axis=-1)
    o_a = hyena_mixer(u_a, conv_w, conv_b, fw1, fb1, fw2, fb2, fw3, fb3, fw4, sin_freq, hy_bias)
    q = rms_norm(q_b.reshape(B, L, DF_HEADS, 2, DF_HEAD_DIM), q_g).transpose(0, 2, 3, 1, 4)
    k = rms_norm(k_b.reshape(B, L, DF_HEADS, 2, DF_HEAD_DIM), k_g).transpose(0, 2, 3, 1, 4)
    v = v_b.reshape(B, L, DF_HEADS, DF_V_DIM).transpose(0, 2, 1, 3)
    lam_init = 0.8 - 0.6 * math.exp(-0.3 * layer)
    lam = (jnp.exp(jnp.sum(lam_q1.astype(F32) * lam_k1.astype(F32)))
           - jnp.exp(jnp.sum(lam_q2.astype(F32) * lam_k2.astype(F32))) + lam_init)
    o_b = diff_attention(q, k, v, lam, alibi_slopes(DF_HEADS))
    o_b = rms_norm(o_b, subln_g) * (1.0 - lam_init)
    o_b = o_b.transpose(0, 2, 1, 3).reshape(B, L, DF_WIDTH)
    return jnp.concatenate([o_a, o_b.astype(o_a.dtype)], axis=-1) @ w_out


def chunk_gla(q, k, v, logf):
    B, H, L, dk = q.shape
    dv = v.shape[-1]
    n = L // HG_CHUNK

    def chunks(a):
        return jnp.moveaxis(a.reshape(B, H, n, HG_CHUNK, a.shape[-1]), 2, 0)

    lower = jnp.tril(jnp.ones((HG_CHUNK, HG_CHUNK), dtype=bool))[:, :, None]

    def step(state, inp):
        qc, kc, vc, gc = inp
        b = jnp.cumsum(gc, axis=2)
        b_last = b[:, :, -1:, :]
        o_inter = jnp.einsum('bhtk,bhkv->bhtv', qc * jnp.exp(b), state)
        rel = b[:, :, :, None, :] - b[:, :, None, :, :]
        decay = jnp.exp(jnp.where(lower, rel, -jnp.inf))
        att = jnp.einsum('bhtk,bhsk,bhtsk->bhts', qc, kc, decay)
        o_intra = jnp.einsum('bhts,bhsv->bhtv', att, vc)
        state = (jnp.exp(b_last[:, :, 0])[..., None] * state
                 + jnp.einsum('bhsk,bhsv->bhkv', kc * jnp.exp(b_last - b), vc))
        return state, o_inter + o_intra

    s0 = jnp.zeros((B, H, dk, dv), F32)
    _, o = lax.scan(step, s0, (chunks(q), chunks(k), chunks(v), chunks(logf)))
    return jnp.moveaxis(o, 0, 2).reshape(B, H, L, dv)


def hgrn2_mixer(q, fz_f, fz_b, i, g, lb_f, lb_b, norm_g):
    B, L, _ = q.shape

    def heads(a):
        return a.reshape(B, L, HG_HEADS, -1).transpose(0, 2, 1, 3).astype(F32)

    qh = heads(q) * HG_DK ** -0.5
    vh = heads(i)

    def direction(fz, lb, reverse):
        f = lb.astype(F32) + (1.0 - lb.astype(F32)) * jax.nn.sigmoid(fz.astype(F32))
        args = (qh, heads(1.0 - f), vh, heads(jnp.log(f)))
        if reverse:
            args = tuple(jnp.flip(a, axis=2) for a in args)
        o = chunk_gla(*args)
        return jnp.flip(o, axis=2) if reverse else o

    o = direction(fz_f, lb_f, False) + direction(fz_b, lb_b, True)
    o = rms_norm(o, norm_g).transpose(0, 2, 1, 3).reshape(B, L, HG_WIDTH)
    return (o * jax.nn.silu(g.astype(F32))).astype(q.dtype)


def axial_rope_tables(L):
    rows = L // GRID_W
    r, c = jnp.meshgrid(jnp.arange(rows, dtype=F32), jnp.arange(GRID_W, dtype=F32), indexing='ij')
    r = r.reshape(-1)
    c = c.reshape(-1)
    half = GQ_HEAD_DIM // 2
    inv = ROPE_THETA ** (-jnp.arange(0, half, 2, dtype=F32) / half)
    ang_r = r[:, None] * inv[None, :]
    ang_c = c[:, None] * inv[None, :]
    ang = jnp.concatenate([ang_r, ang_r, ang_c, ang_c], axis=-1)
    return jnp.cos(ang), jnp.sin(ang)


def rotate_axial(x, cos, sin):
    x1, x2, x3, x4 = jnp.split(x, 4, axis=-1)
    rot = jnp.concatenate([-x2, x1, -x4, x3], axis=-1)
    return (x.astype(F32) * cos + rot.astype(F32) * sin).astype(x.dtype)


def gqa_attention(q, k, v):
    scale = GQ_HEAD_DIM ** -0.5

    def block(qb, q0):
        s = jnp.einsum('bgrqd,bgkd->bgrqk', qb, k).astype(F32) * scale
        p = jax.nn.softmax(s, axis=-1)
        return jnp.einsum('bgrqk,bgkd->bgrqd', p.astype(v.dtype), v)

    return sweep_query_blocks(block, q)


def odd_mixer(h, lb_f, lb_b, w_in, w_out, hg_norm_g, q_g, k_g):
    B, L, _ = h.shape
    proj = h @ w_in
    bounds = [HG_WIDTH, 2 * HG_WIDTH, 3 * HG_WIDTH, 4 * HG_WIDTH, 5 * HG_WIDTH,
              5 * HG_WIDTH + GQ_WIDTH, 5 * HG_WIDTH + GQ_WIDTH + GQ_KV_WIDTH]
    q_c, fz_f, fz_b, i_c, g_c, q_d, k_d, v_d = jnp.split(proj, bounds, axis=-1)
    o_c = hgrn2_mixer(q_c, fz_f, fz_b, i_c, g_c, lb_f, lb_b, hg_norm_g)
    cos, sin = axial_rope_tables(L)
    cos = cos[:, None, :]
    sin = sin[:, None, :]
    q = rotate_axial(rms_norm(q_d.reshape(B, L, GQ_HEADS, GQ_HEAD_DIM), q_g), cos, sin)
    k = rotate_axial(rms_norm(k_d.reshape(B, L, GQ_KV_HEADS, GQ_HEAD_DIM), k_g), cos, sin)
    q = q.reshape(B, L, GQ_KV_HEADS, GQ_GROUP, GQ_HEAD_DIM).transpose(0, 2, 3, 1, 4)
    k = k.transpose(0, 2, 1, 3)
    v = v_d.reshape(B, L, GQ_KV_HEADS, GQ_HEAD_DIM).transpose(0, 2, 1, 3)
    o_d = gqa_attention(q, k, v).transpose(0, 3, 1, 2, 4).reshape(B, L, GQ_WIDTH)
    return jnp.concatenate([o_c, o_d.astype(o_c.dtype)], axis=-1) @ w_out


def memory_cross_attention(h, mem_n, w_q, w_kv, w_out, q_g, k_g):
    B, L, _ = h.shape
    M = mem_n.shape[1]
    q = rms_norm((h @ w_q).reshape(B, L, CA_HEADS, CA_HEAD_DIM), q_g)
    k, v = jnp.split(mem_n @ w_kv, 2, axis=-1)
    k = rms_norm(k.reshape(B, M, CA_HEADS, CA_HEAD_DIM), k_g)
    v = v.reshape(B, M, CA_HEADS, CA_HEAD_DIM)
    s = jnp.einsum('bqhd,bkhd->bhqk', q, k).astype(F32) * CA_HEAD_DIM ** -0.5
    p = jax.nn.softmax(s, axis=-1)
    o = jnp.einsum('bhqk,bkhd->bqhd', p.astype(v.dtype), v).reshape(B, L, CA_WIDTH)
    return o @ w_out


def setup_inputs(seed: int = 0) -> dict:
    key = jax.random.key(seed)
    ks = jax.random.split(key, 64)
    cnt = [0]

    def nrm(shape, scale):
        k = ks[cnt[0]]
        cnt[0] += 1
        return jax.random.normal(k, shape, jnp.float32) * scale

    def gain(shape):
        return 1.0 + nrm(shape, 0.05)

    ne = (DEPTH + 1) // 2
    no = DEPTH // 2
    D = D_MODEL
    return {
        'x': nrm((BATCH, SEQ, D), 1.0),
        'mem': nrm((BATCH, MEM_LEN, D), 1.0),
        'norm_mix_g': gain((DEPTH, D)),
        'norm_mem_q_g': gain((DEPTH, D)),
        'norm_mem_kv_g': gain((DEPTH, D)),
        'norm_ffn_g': gain((DEPTH, D)),
        'ev_w_in': nrm((ne, D, EVEN_IN), D ** -0.5),
        'ev_w_out': nrm((ne, HY_WIDTH + DF_WIDTH, D), (HY_WIDTH + DF_WIDTH) ** -0.5),
        'hy_conv_w': nrm((ne, HY_SHORT, 3 * HY_WIDTH), HY_SHORT ** -0.5),
        'hy_conv_b': nrm((ne, 3 * HY_WIDTH), 0.02),
        'hy_fw1': nrm((ne, HY_EMB, HY_FILT), HY_EMB ** -0.5),
        'hy_fb1': nrm((ne, HY_FILT), 0.02),
        'hy_fw2': nrm((ne, HY_FILT, HY_FILT), HY_FILT ** -0.5),
        'hy_fb2': nrm((ne, HY_FILT), 0.02),
        'hy_fw3': nrm((ne, HY_FILT, HY_FILT), HY_FILT ** -0.5),
        'hy_fb3': nrm((ne, HY_FILT), 0.02),
        'hy_fw4': nrm((ne, HY_FILT, 2 * HY_WIDTH), 0.1 * HY_FILT ** -0.5),
        'hy_sin_freq': gain((ne, HY_FILT)),
        'hy_bias': nrm((ne, HY_WIDTH), 0.5),
        'df_q_g': gain((ne, DF_HEAD_DIM)),
        'df_k_g': gain((ne, DF_HEAD_DIM)),
        'df_lam_q1': nrm((ne, DF_HEAD_DIM), 0.1),
        'df_lam_k1': nrm((ne, DF_HEAD_DIM), 0.1),
        'df_lam_q2': nrm((ne, DF_HEAD_DIM), 0.1),
        'df_lam_k2': nrm((ne, DF_HEAD_DIM), 0.1),
        'df_subln_g': gain((ne, DF_V_DIM)),
        'od_w_in': nrm((no, D, ODD_IN), D ** -0.5),
        'od_w_out': nrm((no, HG_WIDTH + GQ_WIDTH, D), (HG_WIDTH + GQ_WIDTH) ** -0.5),
        'hg_lb_logits': nrm((2, DEPTH, HG_WIDTH), 0.1),
        'hg_norm_g': gain((no, HG_DV)),
        'gq_q_g': gain((no, GQ_HEAD_DIM)),
        'gq_k_g': gain((no, GQ_HEAD_DIM)),
        'ca_w_q': nrm((DEPTH, D, CA_WIDTH), D ** -0.5),
        'ca_w_kv': nrm((DEPTH, D, 2 * CA_WIDTH), D ** -0.5),
        'ca_w_out': nrm((DEPTH, CA_WIDTH, D), CA_WIDTH ** -0.5),
        'ca_q_g': gain((DEPTH, CA_HEAD_DIM)),
        'ca_k_g': gain((DEPTH, CA_HEAD_DIM)),
        'mlp_w1': nrm((DEPTH, D, FFN_HIDDEN), D ** -0.5),
        'mlp_w2': nrm((DEPTH, FFN_HIDDEN, D), FFN_HIDDEN ** -0.5),
    }


def reference(x, mem, norm_mix_g, norm_mem_q_g, norm_mem_kv_g, norm_ffn_g,
              ev_w_in, ev_w_out, hy_conv_w, hy_conv_b, hy_fw1, hy_fb1, hy_fw2, hy_fb2,
              hy_fw3, hy_fb3, hy_fw4, hy_sin_freq, hy_bias,
              df_q_g, df_k_g, df_lam_q1, df_lam_k1, df_lam_q2, df_lam_k2, df_subln_g,
              od_w_in, od_w_out, hg_lb_logits, hg_norm_g, gq_q_g, gq_k_g,
              ca_w_q, ca_w_kv, ca_w_out, ca_q_g, ca_k_g, mlp_w1, mlp_w2):
    lb_soft = jax.nn.softmax(hg_lb_logits.astype(F32), axis=1)
    lbs = jnp.cumsum(lb_soft, axis=1)
    lbs = lbs - lbs[:, :1]
    for layer in range(DEPTH):
        j = layer // 2
        h = rms_norm(x, norm_mix_g[layer])
        if layer % 2 == 0:
            mix = even_mixer(h, layer, ev_w_in[j], ev_w_out[j], hy_conv_w[j], hy_conv_b[j],
                             hy_fw1[j], hy_fb1[j], hy_fw2[j], hy_fb2[j], hy_fw3[j], hy_fb3[j],
                             hy_fw4[j], hy_sin_freq[j], hy_bias[j], df_q_g[j], df_k_g[j],
                             df_lam_q1[j], df_lam_k1[j], df_lam_q2[j], df_lam_k2[j], df_subln_g[j])
        else:
            mix = odd_mixer(h, lbs[0, layer], lbs[1, layer], od_w_in[j], od_w_out[j],
                            hg_norm_g[j], gq_q_g[j], gq_k_g[j])
        x = x + mix.astype(x.dtype)
        x = x + memory_cross_attention(rms_norm(x, norm_mem_q_g[layer]), rms_norm(mem, norm_mem_kv_g[layer]),
                                       ca_w_q[layer], ca_w_kv[layer], ca_w_out[layer],
                                       ca_q_g[layer], ca_k_g[layer]).astype(x.dtype)
        h = rms_norm(x, norm_ffn_g[layer])
        x = x + (jnp.square(jax.nn.relu(h @ mlp_w1[layer])) @ mlp_w2[layer]).astype(x.dtype)
    return x
```

```cpp
#include <hip/hip_runtime.h>
#include <hip/hip_cooperative_groups.h>
#include <cstdio>
#include <cstdint>
namespace cg = cooperative_groups;

#define DI __device__ __forceinline__
#define LAS __attribute__((address_space(3)))
typedef unsigned short bf16_t;
typedef short bf16x8 __attribute__((ext_vector_type(8)));
typedef short s16x4 __attribute__((ext_vector_type(4)));
typedef float f32x2 __attribute__((ext_vector_type(2)));
typedef float f32x4 __attribute__((ext_vector_type(4)));
typedef float f32x16 __attribute__((ext_vector_type(16)));
typedef unsigned u32x2 __attribute__((ext_vector_type(2)));
typedef unsigned u32x4 __attribute__((ext_vector_type(4)));

constexpr int NTHR = 512;
constexpr int DM = 2048, SEQ = 2048, TOK = 32768, MTOK = 4096;
constexpr int EVEN_IN = 6144, ODD_IN = 6656, FFN = 8192, CAW = 512;
constexpr int LDS_BYTES = 136 * 1024;
constexpr float EPS = 1e-6f;
constexpr float LOG2E = 1.4426950408889634f;

constexpr size_t AL(size_t x) { return (x + 255) & ~(size_t)255; }
constexpr size_t WS_WIN0 = 0;
constexpr size_t WS_WIN1 = WS_WIN0 + AL((size_t)EVEN_IN * DM * 2);
constexpr size_t WS_WOUT = WS_WIN1 + AL((size_t)ODD_IN * DM * 2);
constexpr size_t SZ_WOUT = (size_t)DM * DM * 2;
constexpr size_t WS_CAQ = WS_WOUT + 2 * SZ_WOUT;
constexpr size_t SZ_CAQ = (size_t)CAW * DM * 2;
constexpr size_t WS_CAKV = WS_CAQ + 2 * SZ_CAQ;
constexpr size_t SZ_CAKV = (size_t)2 * CAW * DM * 2;
constexpr size_t WS_CAO = WS_CAKV + 2 * SZ_CAKV;
constexpr size_t SZ_CAO = (size_t)DM * CAW * 2;
constexpr size_t WS_W1 = WS_CAO + 2 * SZ_CAO;
constexpr size_t SZ_W1 = (size_t)FFN * DM * 2;
constexpr size_t WS_W2 = WS_W1 + 2 * SZ_W1;
constexpr size_t WS_P = WS_W2 + 2 * SZ_W1;
constexpr size_t SZ_P = (size_t)TOK * FFN * 2;
constexpr size_t WS_HB = WS_P + SZ_P;
constexpr size_t SZ_HB = (size_t)TOK * DM * 2;
constexpr size_t WS_OB = WS_HB + SZ_HB;
constexpr size_t SZ_OB = (size_t)TOK * 1024 * 2;
constexpr size_t WS_MEMN = WS_OB + SZ_OB;
constexpr size_t SZ_MEMN = (size_t)MTOK * DM * 2;
constexpr size_t WS_KV = WS_MEMN + 2 * SZ_MEMN;
constexpr size_t SZ_KV = (size_t)MTOK * 1024 * 2;
constexpr size_t WS_FILT = WS_KV + 2 * SZ_KV;
constexpr size_t WS_BAR = WS_FILT + (size_t)1024 * 4096 * 2;
constexpr size_t WS_SSQ = WS_BAR + 16384;
constexpr size_t WS_ROPE = WS_SSQ + (size_t)TOK * 32 * 4;
constexpr size_t WS_END = WS_ROPE + 64 * 32 * 8;
static_assert(WS_END <= (size_t)1073741824, "workspace budget");
constexpr size_t P_UT = 0;
constexpr size_t P_QKV0 = (size_t)3072 * TOK * 2;
constexpr size_t P_OAT = P_QKV0 + (size_t)TOK * 3072 * 2;
constexpr size_t P_SCR = P_OAT + (size_t)1024 * TOK * 2;
constexpr size_t P_XB = 0;
constexpr size_t P_QC = (size_t)TOK * DM * 2;
constexpr size_t P_OC = P_QC + (size_t)TOK * CAW * 2;
constexpr size_t P_OF = (size_t)TOK * ODD_IN * 2;
static_assert(P_SCR + (size_t)256 * 131072 <= SZ_P && P_OF + SZ_OB <= SZ_P, "P layout");

struct Params {
    const float* in[39];
    float* out;
    unsigned char* ws;
};
typedef const Params __attribute__((address_space(4)))* PPtr;
DI PPtr fresh_params() { PPtr q = (PPtr)__builtin_amdgcn_kernarg_segment_ptr(); asm volatile("" : "+s"(q)); return q; }
enum { I_X = 0, I_MEM, I_NMIX, I_NMQ, I_NMKV, I_NFFN, I_EVWIN, I_EVWOUT, I_HYCW, I_HYCB, I_FW1, I_FB1, I_FW2, I_FB2, I_FW3, I_FB3, I_FW4,
       I_SINF, I_HYBIAS, I_DFQG, I_DFKG, I_LQ1, I_LK1, I_LQ2, I_LK2, I_SUBLN, I_ODWIN, I_ODWOUT, I_LBLOG, I_HGNG, I_GQQG, I_GQKG,
       I_CAWQ, I_CAWKV, I_CAWO, I_CAQG, I_CAKG, I_W1, I_W2 };

DI unsigned cvt_pk_bf16(float lo, float hi) { unsigned r; asm volatile("v_cvt_pk_bf16_f32 %0, %1, %2" : "=v"(r) : "v"(lo), "v"(hi)); return r; }
DI bf16_t f2bf(float x) { return (bf16_t)(cvt_pk_bf16(x, 0.f) & 0xffffu); }
DI bf16_t f2bf_c(float x) { unsigned u = __float_as_uint(x); u += 0x7fffu + ((u >> 16) & 1u); return (bf16_t)(u >> 16); }
DI float bf2f(bf16_t b) { return __uint_as_float(((unsigned)b) << 16); }
DI float bflo(unsigned u) { return __uint_as_float(u << 16); }
DI float bfhi(unsigned u) { return __uint_as_float(u & 0xffff0000u); }
DI int otid() { int t = threadIdx.x; asm volatile("" : "+v"(t)); return t; }
template <class T> DI const T* launder(const T* p) { asm volatile("" : "+s"(p)); return p; }
DI float wave_sum(float v) {
#pragma unroll
    for (int o = 32; o > 0; o >>= 1) v += __shfl_xor(v, o);
    return v;
}

namespace pg8 {
constexpr int BM = 256, BK = 64, HALF = 128, HTB = HALF * BK * 2, STAGE_BYTES = 8 * HTB, NXCD = 8, WGM = 8;
DI int lds_byte(int r, int c) { const int st = (r >> 4) * 2 + (c >> 5), rr = r & 15, cc = c & 31, ob = rr * 64 + cc * 2; return st * 1024 + (ob ^ (((ob >> 9) & 1) << 5)); }
DI void stage_rc(int b, int& R, int& C) { const int st = b / 1024, sb = b % 1024, swz = sb ^ (((sb >> 9) & 1) << 5); R = (st >> 1) * 16 + swz / 64; C = (st & 1) * 32 + (swz % 64) / 2; }
DI int perm32(int rho) { const int n = rho >> 4, i = rho & 15; return 8 * (i >> 2) + 4 * n + (i & 3); }
struct Unit { int pm, pn; };
struct Gemm { const bf16_t* A; const bf16_t* Bt; int M, N, K; };
struct StaticOrder {
    int nM, nN, nwg, G, c, wgm;
    DI void init(int M, int N, int G_, int c_, int wgm_ = WGM) { nM = M / BM; nN = N / BM; nwg = nM * nN; G = G_; c = c_; wgm = wgm_; }
    DI bool next(int i, Unit& u) const {
        const long L = (long)i * G + c; if (L >= nwg) return false;
        int wgid = (int)L; { const int q = nwg / NXCD, r = nwg % NXCD, xcd = wgid % NXCD, off = wgid / NXCD; wgid = (xcd < r ? xcd * (q + 1) : r * (q + 1) + (xcd - r) * q) + off; }
        const int nig = wgm * nN, gid = wgid / nig, fm = gid * wgm, gsz = (nM - fm) < wgm ? (nM - fm) : wgm;
        u.pm = fm + ((wgid % nig) % gsz); u.pn = (wgid % nig) / gsz; return true;
    }
};
template <int ACT  , bool SCALE = false> struct EpiBf16 {
    static constexpr bool PERM = true;
    bf16_t* O; int ldc; const float* SSQ;
    DI void pre(const Unit& u, int wr, int fr, int fq, float (&pf)[8]) const {
        if (SCALE) { const int row0 = u.pm * BM + wr * 64 + fr;
#pragma unroll
            for (int ai = 0; ai < 2; ++ai)
#pragma unroll
                for (int m = 0; m < 4; ++m) { const f32x4* sp = (const f32x4*)(SSQ + (size_t)(row0 + ai * HALF + m * 16) * 32) + 2 * fq; const f32x4 t = sp[0] + sp[1]; pf[ai * 4 + m] = (t[0] + t[1]) + (t[2] + t[3]); } }
    }
    DI void operator()(const f32x4 (&acc)[2][2][4][2], const Unit& u, int wr, int wc, int fr, int fq, const float (&pf)[8]) const {
        const int row0 = u.pm * BM + wr * 64 + fr, col0 = u.pn * BM + wc * 32 + 8 * fq;
#pragma unroll
        for (int ai = 0; ai < 2; ++ai)
#pragma unroll
            for (int m = 0; m < 4; ++m) { bf16_t* rowp = O + (size_t)(row0 + ai * HALF + m * 16) * ldc + col0;
                float rs = 1.f;
                if (SCALE) { float ts = pf[ai * 4 + m]; ts += __shfl_xor(ts, 16); ts += __shfl_xor(ts, 32); rs = rsqrtf(ts * (1.f / DM) + EPS); }
#pragma unroll
                for (int bj = 0; bj < 2; ++bj) { f32x4 v0, v1;
                    if (SCALE) { v0 = acc[ai][bj][m][0] * rs; v1 = acc[ai][bj][m][1] * rs; }
                    else { v0 = acc[ai][bj][m][0] + (f32x4){0.f, 0.f, 0.f, 0.f}; v1 = acc[ai][bj][m][1] + (f32x4){0.f, 0.f, 0.f, 0.f}; }
                    if (ACT == 1) {
#pragma unroll
                        for (int j = 0; j < 4; ++j) { float a = fmaxf(v0[j], 0.f), b = fmaxf(v1[j], 0.f); v0[j] = a * a; v1[j] = b * b; } }
                    u32x4 w; w.x = cvt_pk_bf16(v0[0], v0[1]); w.y = cvt_pk_bf16(v0[2], v0[3]); w.z = cvt_pk_bf16(v1[0], v1[1]); w.w = cvt_pk_bf16(v1[2], v1[3]);
                    *(u32x4*)(rowp + bj * HALF) = w; } }
    }
};
struct EpiResNorm {
    static constexpr bool PERM = false;
    const float* R; float* C; bf16_t* XB; float* SSQ; int ldc;
    DI void pre(const Unit&, int, int, int, float (&)[8]) const {}
    DI void operator()(const f32x4 (&acc)[2][2][4][2], const Unit& u, int wr, int wc, int fr, int fq, const float (&)[8]) const {
        const int row0 = u.pm * BM + wr * 64 + fr, col0 = u.pn * BM + wc * 32 + 4 * fq;
        f32x4 ra[2][2][2], rb[2][2][2], rc[2][2][2];
#define EPI_LD2(DST, AI, M0) do { _Pragma("unroll") for (int mm = 0; mm < 2; ++mm) _Pragma("unroll") for (int bj = 0; bj < 2; ++bj) _Pragma("unroll") for (int n = 0; n < 2; ++n) \
        DST[mm][bj][n] = *(const f32x4*)(R + (size_t)(row0 + (AI) * HALF + ((M0) + mm) * 16) * ldc + col0 + bj * HALF + n * 16); } while (0)
#define EPI_ST2(SRC, AI, M0) do { _Pragma("unroll") for (int mm = 0; mm < 2; ++mm) { const size_t off = (size_t)(row0 + (AI) * HALF + ((M0) + mm) * 16) * ldc + col0; float ss = 0.f; \
        _Pragma("unroll") for (int bj = 0; bj < 2; ++bj) _Pragma("unroll") for (int n = 0; n < 2; ++n) { const f32x4 v = SRC[mm][bj][n] + acc[AI][bj][(M0) + mm][n]; \
            *(f32x4*)(C + off + bj * HALF + n * 16) = v; ss += v[0] * v[0] + v[1] * v[1] + v[2] * v[2] + v[3] * v[3]; \
            u32x2 w; w.x = cvt_pk_bf16(v[0], v[1]); w.y = cvt_pk_bf16(v[2], v[3]); *(u32x2*)(XB + off + bj * HALF + n * 16) = w; } \
        ss += __shfl_xor(ss, 16); ss += __shfl_xor(ss, 32); \
        if (fq == 0) SSQ[(size_t)(row0 + (AI) * HALF + ((M0) + mm) * 16) * 32 + u.pn * 4 + wc] = ss; } } while (0)
        EPI_LD2(ra, 0, 0); EPI_LD2(rb, 0, 2);
        EPI_ST2(ra, 0, 0); EPI_LD2(rc, 1, 0);
        EPI_ST2(rb, 0, 2); EPI_LD2(ra, 1, 2);
        EPI_ST2(rc, 1, 0);
        EPI_ST2(ra, 1, 2);
#undef EPI_ST2
#undef EPI_LD2
    }
};
struct EpiResF32 {
    static constexpr bool PERM = false;
    const float* R; float* C; int ldc;
    DI void pre(const Unit&, int, int, int, float (&)[8]) const {}
    DI void operator()(const f32x4 (&acc)[2][2][4][2], const Unit& u, int wr, int wc, int fr, int fq, const float (&)[8]) const {
        const int row0 = u.pm * BM + wr * 64 + fr, col0 = u.pn * BM + wc * 32 + 4 * fq;
#pragma unroll
        for (int ai = 0; ai < 2; ++ai) {
            f32x4 rv[4][2][2];
#pragma unroll
            for (int m = 0; m < 4; ++m)
#pragma unroll
                for (int bj = 0; bj < 2; ++bj)
#pragma unroll
                    for (int n = 0; n < 2; ++n) rv[m][bj][n] = *(const f32x4*)(R + (size_t)(row0 + ai * HALF + m * 16) * ldc + col0 + bj * HALF + n * 16);
#pragma unroll
            for (int m = 0; m < 4; ++m) { const size_t off = (size_t)(row0 + ai * HALF + m * 16) * ldc + col0;
#pragma unroll
                for (int bj = 0; bj < 2; ++bj)
#pragma unroll
                    for (int n = 0; n < 2; ++n) *(f32x4*)(C + off + bj * HALF + n * 16) = rv[m][bj][n] + acc[ai][bj][m][n]; }
        }
    }
};

template <class Epi, class Sched>
DI void gemm_phase(LAS unsigned char* lds, const Gemm g, const Sched& S, const Epi& E) {
    const int tid = otid(), wid = __builtin_amdgcn_readfirstlane(tid >> 6), lane = tid & 63, wr = wid >> 2, wc = wid & 3, fr = lane & 15, fq = lane >> 4;
    const int K = g.K, nt = K / BK;
    unsigned voffA[2], voffB[2];
#pragma unroll
    for (int i = 0; i < 2; ++i) { int R, C; stage_rc(tid * 16 + i * 8192, R, C); const int Rb = Epi::PERM ? ((R & ~31) + perm32(R & 31)) : R;
        voffA[i] = (unsigned)(R * K + C) * 2u; voffB[i] = (unsigned)(Rb * K + C) * 2u; }
    const size_t kstep = (size_t)(BK * 2);
    const size_t hstep = (size_t)HALF * K * 2;
    const size_t tstep = 2 * hstep;
    const unsigned ldsw = (unsigned)wid * 1024u;
    const int aoff = lds_byte(wr * 64 + fr, fq * 8), boff = lds_byte(wc * 32 + fr, fq * 8);
#define PG8_SA(b, h) (((b) * 2 + (h)) * HTB)
#define PG8_SB(b, h) ((4 + (b) * 2 + (h)) * HTB)
#define PG8_STAGE(bufoff, gbase, voff) do { _Pragma("unroll") for (int _i = 0; _i < 2; ++_i) \
        __builtin_amdgcn_global_load_lds((const unsigned*)((const char*)(gbase) + (voff)[_i]), (LAS unsigned*)(lds + (bufoff) + ldsw + _i * 8192), 16, 0, 0); } while (0)
#define PG8_LDA(dst, b, h) do { _Pragma("unroll") for (int m = 0; m < 4; ++m) _Pragma("unroll") for (int k = 0; k < 2; ++k) dst[m][k] = *(const LAS bf16x8*)(lds + PG8_SA(b, h) + aoff + m * 2048 + k * 1024); } while (0)
#define PG8_LDB(dst, b, h) do { _Pragma("unroll") for (int n = 0; n < 2; ++n) _Pragma("unroll") for (int k = 0; k < 2; ++k) dst[n][k] = *(const LAS bf16x8*)(lds + PG8_SB(b, h) + boff + n * 2048 + k * 1024); } while (0)
#define PG8_MMA(ai, bj, At, Bt) do { __builtin_amdgcn_s_setprio(1); _Pragma("unroll") for (int m = 0; m < 4; ++m) _Pragma("unroll") for (int n = 0; n < 2; ++n) _Pragma("unroll") for (int k = 0; k < 2; ++k) \
        acc[ai][bj][m][n] = __builtin_amdgcn_mfma_f32_16x16x32_bf16(Bt[n][k], At[m][k], acc[ai][bj][m][n], 0, 0, 0); __builtin_amdgcn_s_setprio(0); } while (0)
#define PG8_WAIT_V(n) asm volatile("s_waitcnt vmcnt(" #n ")" ::: "memory")
#define PG8_WAIT_L(n) asm volatile("s_waitcnt lgkmcnt(" #n ")" ::: "memory")
#define PG8_BAR __builtin_amdgcn_s_barrier()
#define PG8_SCHED __builtin_amdgcn_sched_barrier(0)
    Unit cur, nxt; int ui = 0;
    if (!S.next(0, cur)) return;
    f32x4 acc[2][2][4][2];
#pragma unroll
    for (int a = 0; a < 2; ++a)
#pragma unroll
        for (int b = 0; b < 2; ++b)
#pragma unroll
            for (int m = 0; m < 4; ++m)
#pragma unroll
                for (int n = 0; n < 2; ++n) acc[a][b][m][n] = (f32x4){0.f, 0.f, 0.f, 0.f};
    bf16x8 At[4][2], B0[2][2], B1[2][2];
    const char* cA = (const char*)g.A + (size_t)cur.pm * tstep; const char* cB = (const char*)g.Bt + (size_t)cur.pn * tstep;
    float pf[8] = {0.f, 0.f, 0.f, 0.f, 0.f, 0.f, 0.f, 0.f};
    E.pre(cur, wr, fr, fq, pf);
    PG8_STAGE(PG8_SB(0, 0), cB, voffB); PG8_STAGE(PG8_SA(0, 0), cA, voffA); PG8_STAGE(PG8_SB(0, 1), cB + hstep, voffB); PG8_STAGE(PG8_SA(0, 1), cA + hstep, voffA);
    if (wr == 1) PG8_BAR;
    PG8_WAIT_V(4); PG8_BAR;
    PG8_STAGE(PG8_SB(1, 0), cB + kstep, voffB); PG8_STAGE(PG8_SA(1, 0), cA + kstep, voffA); PG8_STAGE(PG8_SB(1, 1), cB + hstep + kstep, voffB);
    PG8_WAIT_V(6); PG8_BAR;
    for (;;) {
        const bool has_next = S.next(ui + 1, nxt);
        const char* nA = has_next ? (const char*)g.A + (size_t)nxt.pm * tstep : cA; const char* nB = has_next ? (const char*)g.Bt + (size_t)nxt.pn * tstep : cB;
        for (int t = 0; t < nt; t += 2) {
            const bool last = (t == nt - 2);
            const char* a1 = cA + (size_t)(t + 1) * kstep;
            const char* a2 = last ? nA : cA + (size_t)(t + 2) * kstep; const char* b2 = last ? nB : cB + (size_t)(t + 2) * kstep;
            const char* a3 = a2 + kstep; const char* b3 = b2 + kstep;
            PG8_LDB(B0, 0, 0); PG8_SCHED; PG8_LDA(At, 0, 0); PG8_STAGE(PG8_SA(1, 1), a1 + hstep, voffA);
            PG8_WAIT_L(8); PG8_BAR; PG8_WAIT_L(0); PG8_MMA(0, 0, At, B0); PG8_BAR; PG8_SCHED;
            PG8_LDB(B1, 0, 1); PG8_STAGE(PG8_SB(0, 0), b2, voffB);
            PG8_BAR; PG8_WAIT_L(0); PG8_MMA(0, 1, At, B1); PG8_BAR;
            PG8_LDA(At, 0, 1); PG8_STAGE(PG8_SA(0, 0), a2, voffA);
            PG8_BAR; PG8_WAIT_L(0); PG8_MMA(1, 0, At, B0); PG8_BAR; PG8_SCHED;
            PG8_STAGE(PG8_SB(0, 1), b2 + hstep, voffB);
            PG8_WAIT_V(6); PG8_BAR; PG8_MMA(1, 1, At, B1); PG8_BAR;
            PG8_LDB(B0, 1, 0); PG8_SCHED; PG8_LDA(At, 1, 0); PG8_STAGE(PG8_SA(0, 1), a2 + hstep, voffA);
            PG8_WAIT_L(8); PG8_BAR; PG8_WAIT_L(0); PG8_MMA(0, 0, At, B0); PG8_BAR; PG8_SCHED;
            PG8_LDB(B1, 1, 1); PG8_STAGE(PG8_SB(1, 0), b3, voffB);
            PG8_BAR; PG8_WAIT_L(0); PG8_MMA(0, 1, At, B1); PG8_BAR;
            PG8_LDA(At, 1, 1); PG8_STAGE(PG8_SA(1, 0), a3, voffA);
            PG8_BAR; PG8_WAIT_L(0); PG8_MMA(1, 0, At, B0); PG8_BAR; PG8_SCHED;
            PG8_STAGE(PG8_SB(1, 1), b3 + hstep, voffB);
            PG8_WAIT_V(6); PG8_BAR; PG8_MMA(1, 1, At, B1); PG8_BAR;
        }
        E(acc, cur, wr, wc, fr, fq, pf);
        if (!has_next) break;
#pragma unroll
        for (int a = 0; a < 2; ++a)
#pragma unroll
            for (int b = 0; b < 2; ++b)
#pragma unroll
                for (int m = 0; m < 4; ++m)
#pragma unroll
                    for (int n = 0; n < 2; ++n) acc[a][b][m][n] = (f32x4){0.f, 0.f, 0.f, 0.f};
        cur = nxt; cA = nA; cB = nB; ++ui;
        E.pre(cur, wr, fr, fq, pf);
    }
    PG8_WAIT_V(0);
    if (wr == 0) PG8_BAR;
    PG8_BAR;
#undef PG8_SA
#undef PG8_SB
#undef PG8_STAGE
#undef PG8_LDA
#undef PG8_LDB
#undef PG8_MMA
#undef PG8_WAIT_V
#undef PG8_WAIT_L
#undef PG8_BAR
#undef PG8_SCHED
}
}

template <class Epi>
DI void run_gemm(unsigned char* lds, const bf16_t* A, const bf16_t* Bt, int M, int N, int K, const Epi& E, int rot, int wgm = pg8::WGM) {
    pg8::Gemm g{A, Bt, M, N, K}; pg8::StaticOrder S; S.init(M, N, (int)gridDim.x, (int)((blockIdx.x + rot) % gridDim.x), wgm);
    pg8::gemm_phase<Epi, pg8::StaticOrder>((LAS unsigned char*)lds, g, S, E);
    __syncthreads();
}

#define SBAR() __builtin_amdgcn_sched_barrier(0)
DI int crow(int r, int hi) { return (r & 3) + 8 * (r >> 2) + 4 * hi; }
template <int DQK> struct KL;
template <> struct KL<128> { DI static int off(int row, int colB) { return row * 256 + (colB ^ ((row & 7) << 4)); } };
template <> struct KL<64> { DI static int off(int row, int colB) { return row * 144 + colB; } };
constexpr int ATT_SHM_V = 64 * 128 * 2, ATT_SHM_K = 64 * 128 * 2;
constexpr float ATT_THR2 = 8.f * LOG2E;

template <bool ALIBI>
DI void partialSM(f32x16& p0, f32x16& p1, float& m_reg, float& alpha, float C, float slope2, int dbh  ) {
    float pmax;
    if (ALIBI) {
        const float df = (float)dbh * slope2, s1 = slope2, s2 = 2.f * slope2, s3 = 3.f * slope2, s8 = 8.f * slope2;
#pragma unroll
        for (int q = 0; q < 4; ++q) { const float d0 = df - (float)q * s8, d1 = df - (float)(q + 4) * s8;
            p0[4 * q + 0] = fmaf(p0[4 * q + 0], C, -fabsf(d0));      p1[4 * q + 0] = fmaf(p1[4 * q + 0], C, -fabsf(d1));
            p0[4 * q + 1] = fmaf(p0[4 * q + 1], C, -fabsf(d0 - s1)); p1[4 * q + 1] = fmaf(p1[4 * q + 1], C, -fabsf(d1 - s1));
            p0[4 * q + 2] = fmaf(p0[4 * q + 2], C, -fabsf(d0 - s2)); p1[4 * q + 2] = fmaf(p1[4 * q + 2], C, -fabsf(d1 - s2));
            p0[4 * q + 3] = fmaf(p0[4 * q + 3], C, -fabsf(d0 - s3)); p1[4 * q + 3] = fmaf(p1[4 * q + 3], C, -fabsf(d1 - s3)); }
        pmax = p0[0];
#pragma unroll
        for (int r = 1; r < 16; ++r) pmax = fmaxf(pmax, p0[r]);
#pragma unroll
        for (int r = 0; r < 16; ++r) pmax = fmaxf(pmax, p1[r]);
    } else {
        pmax = p0[0];
#pragma unroll
        for (int r = 1; r < 16; ++r) pmax = fmaxf(pmax, p0[r]);
#pragma unroll
        for (int r = 0; r < 16; ++r) pmax = fmaxf(pmax, p1[r]);
        pmax *= C;
    }
    { auto rr = __builtin_amdgcn_permlane32_swap(__float_as_uint(pmax), __float_as_uint(pmax), false, false);
      pmax = fmaxf(__uint_as_float(rr[0]), __uint_as_float(rr[1])); }
    if (ALIBI) {
        if (__builtin_expect(__all(pmax <= ATT_THR2), 1)) { alpha = 1.f; }
        else { const float d = fmaxf(pmax, 0.f); alpha = __builtin_amdgcn_exp2f(-d); m_reg += d;
#pragma unroll
            for (int r = 0; r < 16; ++r) { p0[r] -= d; p1[r] -= d; } }
    } else {
        float mn;
        if (__builtin_expect(__all(pmax - m_reg <= ATT_THR2), 1)) { mn = m_reg; alpha = 1.f; }
        else { mn = fmaxf(m_reg, pmax); alpha = __builtin_amdgcn_exp2f(m_reg - mn); m_reg = mn; }
#pragma unroll
        for (int r = 0; r < 16; ++r) { p0[r] = fmaf(p0[r], C, -mn); p1[r] = fmaf(p1[r], C, -mn); }
    }
#pragma unroll
    for (int r = 0; r < 16; ++r) p0[r] = __builtin_amdgcn_exp2f(p0[r]);
}
DI void finishSM(f32x16& p0, f32x16& p1, float alpha, float& l_reg, bf16x8& pa0, bf16x8& pa1, bf16x8& pa2, bf16x8& pa3) {
#pragma unroll
    for (int r = 0; r < 16; ++r) p1[r] = __builtin_amdgcn_exp2f(p1[r]);
    float ps = 0;
#pragma unroll
    for (int r = 0; r < 16; ++r) ps += p0[r];
#pragma unroll
    for (int r = 0; r < 16; ++r) ps += p1[r];
    { auto rr = __builtin_amdgcn_permlane32_swap(__float_as_uint(ps), __float_as_uint(ps), false, false);
      ps = __uint_as_float(rr[0]) + __uint_as_float(rr[1]); }
    l_reg = l_reg * alpha + ps;
#define PK4(P, BASE, OUT) do { unsigned a0 = cvt_pk_bf16(P[BASE + 0], P[BASE + 1]), a1 = cvt_pk_bf16(P[BASE + 2], P[BASE + 3]);   \
    unsigned b0 = cvt_pk_bf16(P[BASE + 4], P[BASE + 5]), b1 = cvt_pk_bf16(P[BASE + 6], P[BASE + 7]);                              \
    auto r0 = __builtin_amdgcn_permlane32_swap(a0, b0, false, false); auto r1 = __builtin_amdgcn_permlane32_swap(a1, b1, false, false); \
    u32x4 w = {r0[0], r1[0], r0[1], r1[1]}; OUT = *reinterpret_cast<bf16x8*>(&w); } while (0)
    PK4(p0, 0, pa0); PK4(p0, 8, pa1); PK4(p1, 0, pa2); PK4(p1, 8, pa3);
#undef PK4
}
template <int DQK>
DI void qkt(f32x16& p0, f32x16& p1, const char* Ks, const bf16x8* qr, int r32, int hi, float init) {
#pragma unroll
    for (int i = 0; i < 16; ++i) { p0[i] = init; p1[i] = init; }
    __builtin_amdgcn_s_setprio(1);
#pragma unroll
    for (int d0 = 0; d0 < DQK / 16; ++d0) { const int cb = (d0 * 16 + hi * 8) * 2;
        bf16x8 b0 = *reinterpret_cast<const bf16x8*>(Ks + KL<DQK>::off(r32, cb));
        bf16x8 b1 = *reinterpret_cast<const bf16x8*>(Ks + KL<DQK>::off(32 + r32, cb));
        p0 = __builtin_amdgcn_mfma_f32_32x32x16_bf16(b0, qr[d0], p0, 0, 0, 0);
        p1 = __builtin_amdgcn_mfma_f32_32x32x16_bf16(b1, qr[d0], p1, 0, 0, 0); }
    __builtin_amdgcn_s_setprio(0);
}
DI int v_st(int k, int c) { const int kk = (k & ~0xC) | ((k & 4) << 1) | ((k & 8) >> 1); return ((kk >> 3) * 4 + (c >> 5)) * 512 + ((kk & 7) * 32 + (c & 31)) * 2; }
DI int v_rd_base(int lane) { return ((lane & 3) << 3) | (((lane >> 2) & 3) << 6) | (((lane >> 4) & 1) << 5) | (((lane >> 5) & 1) << 8); }
constexpr int v_rd_off(int d0, int ks, int half) { return d0 * 512 + ks * 4096 + half * 2048; }
template <int OFF> DI s16x4 tr_read(int vb) {
    s16x4 r; asm volatile("ds_read_b64_tr_b16 %0, %1 offset:%2" : "=&v"(r) : "v"(vb), "i"(OFF) : "memory"); return r;
}
template <int D0> DI void pv_one(f32x16& od, int vb, bf16x8 pa0, bf16x8 pa1, bf16x8 pa2, bf16x8 pa3) {
    const s16x4 l0 = tr_read<v_rd_off(D0, 0, 0)>(vb), h0 = tr_read<v_rd_off(D0, 0, 1)>(vb), l1 = tr_read<v_rd_off(D0, 1, 0)>(vb), h1 = tr_read<v_rd_off(D0, 1, 1)>(vb);
    const s16x4 l2 = tr_read<v_rd_off(D0, 2, 0)>(vb), h2 = tr_read<v_rd_off(D0, 2, 1)>(vb), l3 = tr_read<v_rd_off(D0, 3, 0)>(vb), h3 = tr_read<v_rd_off(D0, 3, 1)>(vb);
    asm volatile("s_waitcnt lgkmcnt(0)" ::: "memory"); SBAR();
#define PKV(L, H) (bf16x8){L[0], L[1], L[2], L[3], H[0], H[1], H[2], H[3]}
    __builtin_amdgcn_s_setprio(1);
    od = __builtin_amdgcn_mfma_f32_32x32x16_bf16(pa0, PKV(l0, h0), od, 0, 0, 0);
    od = __builtin_amdgcn_mfma_f32_32x32x16_bf16(pa1, PKV(l1, h1), od, 0, 0, 0);
    od = __builtin_amdgcn_mfma_f32_32x32x16_bf16(pa2, PKV(l2, h2), od, 0, 0, 0);
    od = __builtin_amdgcn_mfma_f32_32x32x16_bf16(pa3, PKV(l3, h3), od, 0, 0, 0);
    __builtin_amdgcn_s_setprio(0);
#undef PKV
}
DI void pv_d0(f32x16* o, int vb, bf16x8 pa0, bf16x8 pa1, bf16x8 pa2, bf16x8 pa3) {
    pv_one<0>(o[0], vb, pa0, pa1, pa2, pa3); pv_one<1>(o[1], vb, pa0, pa1, pa2, pa3); pv_one<2>(o[2], vb, pa0, pa1, pa2, pa3); pv_one<3>(o[3], vb, pa0, pa1, pa2, pa3);
}

template <int DQK, bool ALIBI, bool QNORM>
DI void attn_core(const bf16_t* __restrict__ Qb, int ldq, const bf16_t* __restrict__ Kh, int ldk, const bf16_t* __restrict__ Vh, int ldv,
                  int seq, char* lds, float C, float slope2, int qpos0, const float* __restrict__ qg, f32x16 (&o)[4]) {
    const int tid = otid(), wid = tid >> 6, lane = tid & 63, r32 = lane & 31, hi = lane >> 5;
    char* V_lds = lds; char* K_lds = lds + 2 * ATT_SHM_V;
    float* wsf = (float*)(lds + 2 * ATT_SHM_V + 2 * ATT_SHM_K) + wid * 64; float* li_l = wsf; float* al_l = wsf + 32;
    float m_reg = ALIBI ? 0.f : -1e30f, l_reg = 0; const float rC = 1.f / C;
#pragma unroll
    for (int d = 0; d < 4; ++d)
#pragma unroll
        for (int r = 0; r < 16; ++r) o[d][r] = 0.f;
    bf16x8 qr[DQK / 16];
    const bf16_t* Qw = Qb + (long)(wid * 32 + r32) * ldq + hi * 8;
    if (QNORM) {
        qg = launder(qg);
        float ss = 0.f;
        u32x4 raw[DQK / 16];
#pragma unroll
        for (int d0 = 0; d0 < DQK / 16; ++d0) { raw[d0] = *reinterpret_cast<const u32x4*>(Qw + d0 * 16);
#pragma unroll
            for (int e = 0; e < 4; ++e) { float a = bflo(raw[d0][e]), b = bfhi(raw[d0][e]); ss += a * a + b * b; } }
        ss += __shfl_xor(ss, 32);
        const float sc = rsqrtf(ss * (1.f / DQK) + EPS);
#pragma unroll
        for (int d0 = 0; d0 < DQK / 16; ++d0) { const float* gp = qg + d0 * 16 + hi * 8; u32x4 w;
#pragma unroll
            for (int e = 0; e < 4; ++e) w[e] = cvt_pk_bf16(bflo(raw[d0][e]) * sc * gp[2 * e], bfhi(raw[d0][e]) * sc * gp[2 * e + 1]);
            qr[d0] = *reinterpret_cast<bf16x8*>(&w); }
    } else {
#pragma unroll
        for (int d0 = 0; d0 < DQK / 16; ++d0) qr[d0] = *reinterpret_cast<const bf16x8*>(Qw + d0 * 16);
    }
    const int sr = tid >> 4, sc = (tid & 15) * 8, vst0 = v_st(sr, sc), vst1 = v_st(32 + sr, sc);
    const int kr = (DQK == 128) ? sr : (tid >> 3), kc = (DQK == 128) ? sc : (tid & 7) * 8;
    const int vb0 = (int)(uintptr_t)V_lds + v_rd_base(lane);
    bf16x8 vsA0, vsA1, ksA0, ksA1, vsB0, vsB1, ksB0, ksB1;
#define SLOAD(S, k0) do { vs##S##0 = *reinterpret_cast<const bf16x8*>(&Vh[(long)((k0) + sr) * ldv + sc]); vs##S##1 = *reinterpret_cast<const bf16x8*>(&Vh[(long)((k0) + 32 + sr) * ldv + sc]); \
    ks##S##0 = *reinterpret_cast<const bf16x8*>(&Kh[(long)((k0) + kr) * ldk + kc]); if (DQK == 128) ks##S##1 = *reinterpret_cast<const bf16x8*>(&Kh[(long)((k0) + 32 + kr) * ldk + kc]); } while (0)
#define SWRITE(b, S) do { *(bf16x8*)(V_lds + (b) * ATT_SHM_V + vst0) = vs##S##0; *(bf16x8*)(V_lds + (b) * ATT_SHM_V + vst1) = vs##S##1; \
    *(bf16x8*)(K_lds + (b) * ATT_SHM_K + KL<DQK>::off(kr, kc * 2)) = ks##S##0; if (DQK == 128) *(bf16x8*)(K_lds + (b) * ATT_SHM_K + KL<DQK>::off(32 + kr, kc * 2)) = ks##S##1; } while (0)
#define SWAIT() do { if (DQK == 128) asm volatile("s_waitcnt vmcnt(4)" ::: "memory"); else asm volatile("s_waitcnt vmcnt(3)" ::: "memory"); } while (0)
#define RESC(a) do { if (__any((a) < 1.f)) { if (hi == 0) al_l[r32] = (a); asm volatile("s_waitcnt lgkmcnt(0)" ::: "memory"); \
    _Pragma("unroll") for (int d = 0; d < 4; ++d) _Pragma("unroll") for (int r = 0; r < 16; ++r) o[d][r] *= al_l[crow(r, hi)]; } } while (0)
    f32x16 pA0, pA1, pB0, pB1; float alA, alB; bf16x8 pa0, pa1, pa2, pa3; const int NT = seq / 64;
    const int dq = qpos0 + wid * 32 + r32 - 4 * hi;
    SLOAD(A, 0); asm volatile("s_waitcnt vmcnt(0)" ::: "memory"); SWRITE(0, A); __syncthreads();
    qkt<DQK>(pA0, pA1, K_lds, qr, r32, hi, ALIBI ? -m_reg * rC : 0.f); partialSM<ALIBI>(pA0, pA1, m_reg, alA, C, slope2, dq);
    SLOAD(B, 64); if (2 < NT) SLOAD(A, 128);
    SWAIT(); SWRITE(1, B); __syncthreads();
    for (int j = 1; j + 1 < NT; j += 2) {
        SBAR(); qkt<DQK>(pB0, pB1, K_lds + ATT_SHM_K, qr, r32, hi, ALIBI ? -m_reg * rC : 0.f);
        finishSM(pA0, pA1, alA, l_reg, pa0, pa1, pa2, pa3); SBAR();
        SLOAD(B, (j + 2) * 64); SBAR();
        pv_d0(o, vb0, pa0, pa1, pa2, pa3); partialSM<ALIBI>(pB0, pB1, m_reg, alB, C, slope2, dq - j * 64);
        __syncthreads(); SWAIT(); SWRITE(0, A);
        RESC(alB); __syncthreads();
        SBAR(); qkt<DQK>(pA0, pA1, K_lds, qr, r32, hi, ALIBI ? -m_reg * rC : 0.f);
        finishSM(pB0, pB1, alB, l_reg, pa0, pa1, pa2, pa3); SBAR();
        if (j + 3 < NT) SLOAD(A, (j + 3) * 64); SBAR();
        pv_d0(o, vb0 + ATT_SHM_V, pa0, pa1, pa2, pa3); partialSM<ALIBI>(pA0, pA1, m_reg, alA, C, slope2, dq - (j + 1) * 64);
        __syncthreads(); SWAIT(); SWRITE(1, B);
        RESC(alA); __syncthreads();
    }
    SBAR(); qkt<DQK>(pB0, pB1, K_lds + ATT_SHM_K, qr, r32, hi, ALIBI ? -m_reg * rC : 0.f);
    finishSM(pA0, pA1, alA, l_reg, pa0, pa1, pa2, pa3); SBAR();
    pv_d0(o, vb0, pa0, pa1, pa2, pa3); partialSM<ALIBI>(pB0, pB1, m_reg, alB, C, slope2, dq - (NT - 1) * 64);
    __syncthreads(); RESC(alB);
    finishSM(pB0, pB1, alB, l_reg, pa0, pa1, pa2, pa3); SBAR();
    pv_d0(o, vb0 + ATT_SHM_V, pa0, pa1, pa2, pa3);
    if (hi == 0) li_l[r32] = l_reg; asm volatile("s_waitcnt lgkmcnt(0)" ::: "memory");
#pragma unroll
    for (int r = 0; r < 16; ++r) { const float rl = __builtin_amdgcn_rcpf(li_l[crow(r, hi)]);
#pragma unroll
        for (int d = 0; d < 4; ++d) o[d][r] *= rl; }
#undef SLOAD
#undef SWRITE
#undef SWAIT
#undef RESC
}
DI void store_o_bf16(const f32x16 (&o)[4], bf16_t* dst, int ld) {
    const int tid = otid(), wid = tid >> 6, lane = tid & 63, r32 = lane & 31, hi = lane >> 5;
#pragma unroll
    for (int r = 0; r < 16; ++r) { bf16_t* rp = dst + (size_t)(wid * 32 + crow(r, hi)) * ld + r32;
#pragma unroll
        for (int d = 0; d < 4; ++d) rp[d * 32] = f2bf(o[d][r]); }
}

DI void xpose_w(const float* __restrict__ W, bf16_t* __restrict__ Wt, int K, int N, float* lds, const float* __restrict__ g = nullptr) {
    const int tid = otid(), ntk = K / 64, ntn = N / 256, nt = ntk * ntn;
    for (int t = blockIdx.x; t < nt; t += gridDim.x) {
        const int tk = t / ntn, tn = t % ntn;
        f32x4 v[8];
#pragma unroll
        for (int i = 0; i < 8; ++i) { const int r = (tid >> 6) + 8 * i; v[i] = *(const f32x4*)(W + (size_t)(tk * 64 + r) * N + tn * 256 + (tid & 63) * 4); }
        if (g) {
#pragma unroll
            for (int i = 0; i < 8; ++i) v[i] *= g[tk * 64 + (tid >> 6) + 8 * i]; }
        __syncthreads();
#pragma unroll
        for (int i = 0; i < 8; ++i) { float* d = lds + ((tid >> 6) + 8 * i) * 257 + (tid & 63) * 4; d[0] = v[i][0]; d[1] = v[i][1]; d[2] = v[i][2]; d[3] = v[i][3]; }
        __syncthreads();
#pragma unroll
        for (int j = 0; j < 4; ++j) { const int id = tid + NTHR * j, n = id >> 3, k8 = (id & 7) * 8; u32x4 w;
#pragma unroll
            for (int e = 0; e < 4; ++e) w[e] = cvt_pk_bf16(lds[(k8 + 2 * e) * 257 + n], lds[(k8 + 2 * e + 1) * 257 + n]);
            *(u32x4*)(Wt + (size_t)(tn * 256 + n) * K + tk * 64 + k8) = w; }
    }
}
DI void rmsnorm_rows(const float* __restrict__ X, const float* __restrict__ g, bf16_t* __restrict__ H, int rows) {
    const int tidr = otid(); const int lane = tidr & 63, gw = blockIdx.x * 8 + (tidr >> 6), nw = gridDim.x * 8;
    for (int r = gw; r < rows; r += nw) {
        const float* xr = X + (size_t)r * DM; f32x4 v[8]; float ss = 0.f;
#pragma unroll
        for (int i = 0; i < 8; ++i) { v[i] = *(const f32x4*)(xr + i * 256 + lane * 4); ss += v[i][0] * v[i][0] + v[i][1] * v[i][1] + v[i][2] * v[i][2] + v[i][3] * v[i][3]; }
        ss = wave_sum(ss);
        const float sc = rsqrtf(ss * (1.f / DM) + EPS);
#pragma unroll
        for (int i = 0; i < 8; ++i) { const f32x4 gg = *(const f32x4*)(g + i * 256 + lane * 4);
            u32x2 w; w.x = cvt_pk_bf16(v[i][0] * sc * gg[0], v[i][1] * sc * gg[1]); w.y = cvt_pk_bf16(v[i][2] * sc * gg[2], v[i][3] * sc * gg[3]);
            *(u32x2*)(H + (size_t)r * DM + i * 256 + lane * 4) = w; }
    }
}
template <int GD>
DI void groupnorm_tile(bf16_t* __restrict__ B, int ld, int row0, int col0, const float* __restrict__ g) {
    constexpr int TPG = GD / 8, NG = 256 / GD;
    const int tid = otid();
    u32x4 raw[16];
#pragma unroll
    for (int it = 0; it < 16; ++it) { const int i = tid + NTHR * it; const int j = i % TPG, grp = (i / TPG) % NG, row = i / (TPG * NG);
        raw[it] = *(const u32x4*)(B + (size_t)(row0 + row) * ld + col0 + grp * GD + j * 8); }
#pragma unroll
    for (int it = 0; it < 16; ++it) { const int i = tid + NTHR * it; const int j = i % TPG, grp = (i / TPG) % NG, row = i / (TPG * NG);
        bf16_t* p = B + (size_t)(row0 + row) * ld + col0 + grp * GD + j * 8;
        float x[8]; float ss = 0.f;
#pragma unroll
        for (int e = 0; e < 4; ++e) { x[2 * e] = bflo(raw[it][e]); x[2 * e + 1] = bfhi(raw[it][e]); ss += x[2 * e] * x[2 * e] + x[2 * e + 1] * x[2 * e + 1]; }
#pragma unroll
        for (int o = 1; o < TPG; o <<= 1) ss += __shfl_xor(ss, o);
        const float sc = rsqrtf(ss * (1.f / GD) + EPS); u32x4 w;
#pragma unroll
        for (int e = 0; e < 4; ++e) w[e] = cvt_pk_bf16(x[2 * e] * sc * g[j * 8 + 2 * e], x[2 * e + 1] * sc * g[j * 8 + 2 * e + 1]);
        *(u32x4*)p = w;
    }
}
DI void gqa_prep_tile(bf16_t* __restrict__ P1, int row0, int col0, const float* __restrict__ g, const f32x2* __restrict__ rope) {
    const int tid = otid();
    u32x4 rawv[16];
#pragma unroll
    for (int it = 0; it < 16; ++it) { const int i = tid + NTHR * it; const int j = i & 15, hv = (i >> 4) & 1, row = i >> 5;
        rawv[it] = *(const u32x4*)(P1 + (size_t)(row0 + row) * ODD_IN + col0 + hv * 128 + j * 8); }
#pragma unroll
    for (int it = 0; it < 16; ++it) {
        const int i = tid + NTHR * it;
        const int j = i & 15, hv = (i >> 4) & 1, row = i >> 5; const int tok = row0 + row;
        bf16_t* p = P1 + (size_t)tok * ODD_IN + col0 + hv * 128 + j * 8;
        const u32x4 raw = rawv[it]; float x[8]; float ss = 0.f;
#pragma unroll
        for (int e = 0; e < 4; ++e) { x[2 * e] = bflo(raw[e]); x[2 * e + 1] = bfhi(raw[e]); ss += x[2 * e] * x[2 * e] + x[2 * e + 1] * x[2 * e + 1]; }
        ss += __shfl_xor(ss, 1); ss += __shfl_xor(ss, 2); ss += __shfl_xor(ss, 4); ss += __shfl_xor(ss, 8);
        const float sc = rsqrtf(ss * (1.f / 128) + EPS);
        const int t = tok & (SEQ - 1); const int quarter = j >> 2; const int pc = (quarter < 2) ? (t >> 6) : (t & 63);
        const f32x4* rp = (const f32x4*)(rope + pc * 32 + 8 * (j & 3));
        const f32x4 c01 = rp[0], c23 = rp[1], c45 = rp[2], c67 = rp[3];
        const float csv[8] = {c01[0], c01[2], c23[0], c23[2], c45[0], c45[2], c67[0], c67[2]};
        const float snv[8] = {c01[1], c01[3], c23[1], c23[3], c45[1], c45[3], c67[1], c67[3]};
        float y[8], out[8];
#pragma unroll
        for (int e = 0; e < 8; ++e) y[e] = x[e] * sc * g[j * 8 + e];
#pragma unroll
        for (int e = 0; e < 8; ++e) { const float partner = __shfl_xor(y[e], 4);
            out[e] = (quarter & 1) ? (y[e] * csv[e] + partner * snv[e]) : (y[e] * csv[e] - partner * snv[e]); }
        u32x4 w;
#pragma unroll
        for (int e = 0; e < 4; ++e) w[e] = cvt_pk_bf16(out[2 * e], out[2 * e + 1]);
        *(u32x4*)p = w;
    }
}
DI void hgrn_post(const bf16_t* __restrict__ OF, const bf16_t* __restrict__ OBk, const bf16_t* __restrict__ P1, const float* __restrict__ ng, bf16_t* __restrict__ HB) {
    const long total = (long)TOK * 8 * 16;
    for (long i = (long)blockIdx.x * NTHR + otid(); i < total; i += (long)gridDim.x * NTHR) {
        const int j = (int)(i & 15); const long gi = i >> 4; const int h = (int)(gi & 7); const long tok = gi >> 3;
        const size_t off = (size_t)tok * 1024 + h * 128 + j * 8;
        const u32x4 a = *(const u32x4*)(OF + off), b = *(const u32x4*)(OBk + off), gt =
 *(const u32x4*)(P1 + (size_t)tok * ODD_IN + 4096 + h * 128 + j * 8);
        float x[8], gv[8]; float ss = 0.f;
#pragma unroll
        for (int e = 0; e < 4; ++e) { x[2 * e] = bflo(a[e]) + bflo(b[e]); x[2 * e + 1] = bfhi(a[e]) + bfhi(b[e]); gv[2 * e] = bflo(gt[e]); gv[2 * e + 1] = bfhi(gt[e]);
            ss += x[2 * e] * x[2 * e] + x[2 * e + 1] * x[2 * e + 1]; }
        ss += __shfl_xor(ss, 1); ss += __shfl_xor(ss, 2); ss += __shfl_xor(ss, 4); ss += __shfl_xor(ss, 8);
        const float sc = rsqrtf(ss * (1.f / 128) + EPS); float o[8];
#pragma unroll
        for (int e = 0; e < 8; ++e) { const float s = gv[e] / (1.f + __expf(-gv[e])); o[e] = x[e] * sc * ng[j * 8 + e] * s; }
        u32x4 w;
#pragma unroll
        for (int e = 0; e < 4; ++e) w[e] = cvt_pk_bf16(o[2 * e], o[2 * e + 1]);
        *(u32x4*)(HB + (size_t)tok * DM + h * 128 + j * 8) = w;
    }
}
DI void xpose_oat(const bf16_t* __restrict__ OAT, bf16_t* __restrict__ HB, bf16_t* lds) {
    const int tid = otid();
    for (int t = blockIdx.x; t < 16 * 512; t += gridDim.x) {
        const int c0 = (t & 15) * 64, tok0 = (t >> 4) * 64;
        __syncthreads();
        { const int r = tid >> 3, ch = tid & 7; const u32x4 v = *(const u32x4*)(OAT + (size_t)(c0 + r) * TOK + tok0 + ch * 8);
          unsigned* d = (unsigned*)(lds + r * 72 + ch * 8); d[0] = v[0]; d[1] = v[1]; d[2] = v[2]; d[3] = v[3]; }
        __syncthreads();
        { const int tt = tid >> 3, cc = tid & 7; u32x4 w;
#pragma unroll
          for (int e = 0; e < 4; ++e) w[e] = (unsigned)lds[(cc * 8 + 2 * e) * 72 + tt] | ((unsigned)lds[(cc * 8 + 2 * e + 1) * 72 + tt] << 16);
          *(u32x4*)(HB + (size_t)(tok0 + tt) * DM + c0 + cc * 8) = w; }
    }
}
#define p (*pp)
DI void hyena_filters(PPtr pp, float* lds) {
    const int tid = otid(), wid = tid >> 6, lane = tid & 63;
    bf16_t* FILT = (bf16_t*)(p.ws + WS_FILT);
    const float* w1 = p.in[I_FW1]; const float* b1 = p.in[I_FB1]; const float* w2 = p.in[I_FW2]; const float* b2 = p.in[I_FB2];
    const float* w3 = p.in[I_FW3]; const float* b3 = p.in[I_FB3]; const float* w4 = p.in[I_FW4]; const float* sf = p.in[I_SINF];
    float* hb = lds + wid * 128;
    float* W1s = lds + 1024; float* W2s = W1s + 2304; float* W3s = W2s + 4096;
    __syncthreads();
    for (int i = tid; i < 528; i += NTHR) ((f32x4*)W1s)[i] = ((const f32x4*)w1)[i];
    for (int i = tid; i < 1024; i += NTHR) { ((f32x4*)W2s)[i] = ((const f32x4*)w2)[i]; ((f32x4*)W3s)[i] = ((const f32x4*)w3)[i]; }
    for (int grp = blockIdx.x; grp < SEQ / 8; grp += gridDim.x) {
        __syncthreads();
        const int pos = grp * 8 + wid;
        const float tt = (float)pos * (1.f / (SEQ - 1)), ww = (6.283185307179586f / SEQ) * (float)pos;
        float z = 0.f;
        if (lane == 0) z = tt;
        else if (lane <= 16) { const float f = 1e-4f + (float)(lane - 1) * ((15.f - 1e-4f) / 15.f); z = cosf(f * ww); }
        else if (lane <= 32) { const float f = 1e-4f + (float)(lane - 17) * ((15.f - 1e-4f) / 15.f); z = -sinf(f * ww); }
        hb[lane] = z;
        const float fr = sf[lane];
        float a = b1[lane];
#pragma unroll 11
        for (int i = 0; i < 33; ++i) a += hb[i] * W1s[i * 64 + lane];
        hb[64 + lane] = sinf(fr * a);
        a = b2[lane];
#pragma unroll 8
        for (int i = 0; i < 64; ++i) a += hb[64 + i] * W2s[i * 64 + lane];
        hb[lane] = sinf(fr * a);
        a = b3[lane];
#pragma unroll 8
        for (int i = 0; i < 64; ++i) a += hb[i] * W3s[i * 64 + lane];
        hb[64 + lane] = sinf(fr * a);
        __syncthreads();
        {
            const int c0 = 4 * tid;
            f32x4 acc[8];
#pragma unroll
            for (int q = 0; q < 8; ++q) acc[q] = (f32x4){0.f, 0.f, 0.f, 0.f};
#pragma unroll 2
            for (int i4 = 0; i4 < 64; i4 += 4) {
                f32x4 wv[4];
#pragma unroll
                for (int e = 0; e < 4; ++e) wv[e] = *(const f32x4*)(w4 + (size_t)(i4 + e) * 2048 + c0);
#pragma unroll
                for (int q = 0; q < 8; ++q) { const f32x4 hv = *(const f32x4*)(lds + q * 128 + 64 + i4);
                    acc[q] += wv[0] * hv[0] + wv[1] * hv[1] + wv[2] * hv[2] + wv[3] * hv[3]; }
            }
            const int p0 = grp * 8, cw = c0 & 1023;
            bf16_t ov[8][4];
#pragma unroll
            for (int q = 0; q < 8; ++q) { const float tq = (float)(p0 + q) * (1.f / (SEQ - 1));
#pragma unroll
                for (int e = 0; e < 4; ++e) { const float delta = -3.0701134573253945f + (float)(cw + e) * ((-15.350567286626973f + 3.0701134573253945f) / 1023.f);
                    ov[q][e] = f2bf(acc[q][e] * __expf(-tq * fabsf(delta))); } }
            if (c0 < 1024) {
#pragma unroll
                for (int e = 0; e < 4; ++e) { u32x4 w;
#pragma unroll
                    for (int k = 0; k < 4; ++k) w[k] = (unsigned)ov[7 - 2 * k][e] | ((unsigned)ov[6 - 2 * k][e] << 16);
                    *(u32x4*)(FILT + (size_t)(c0 + e) * 4096 + 2040 - p0) = w; }
            } else {
#pragma unroll
                for (int e = 0; e < 4; ++e) { bf16_t* fp = FILT + (size_t)(c0 + e - 1024) * 4096;
#pragma unroll
                    for (int q = 0; q < 8; ++q) { const int ps = p0 + q; if (ps == 0) fp[4095] = 0; else fp[2047 + ps] = ov[q][e]; } }
            }
        }
    }
}

constexpr int HY_CPY = 8224, HY_WROW = 4112, HY_WOFF = 8 * HY_CPY;
DI float conv3(float a, float b, float c, float w0, float w1, float w2, float bias) { return fmaf(a, w0, fmaf(b, w1, fmaf(c, w2, bias))); }
DI void hyena_item(PPtr pp, int c, char* lds) {
    const int tid = otid(), wid = tid >> 6, lane = tid & 63;
    const bf16_t* UT = (const bf16_t*)(p.ws + WS_P + P_UT);
    bf16_t* OAT = (bf16_t*)(p.ws + WS_P + P_OAT);
    const float* cw = p.in[I_HYCW]; const float* cb = p.in[I_HYCB];
    __syncthreads();
    {
        const bf16_t* F = (const bf16_t*)(p.ws + WS_FILT) + (size_t)c * 4096;
        const u32x4 lo = *(const u32x4*)(F + 8 * tid); u32x4 hi4 = {0u, 0u, 0u, 0u};
        if (tid < 511) hi4 = *(const u32x4*)(F + 8 * tid + 8);
        const unsigned d0 = lo[0], d1 = lo[1], d2 = lo[2], d3 = lo[3], d4 = hi4[0], d5 = hi4[1], d6 = hi4[2], d7 = hi4[3];
#define HY_AL(hi_, lo_) __builtin_amdgcn_alignbit(hi_, lo_, 16)
        *(u32x4*)(lds + 0 * HY_CPY + tid * 16) = (u32x4){d0, d1, d2, d3};
        *(u32x4*)(lds + 1 * HY_CPY + tid * 16) = (u32x4){HY_AL(d1, d0), HY_AL(d2, d1), HY_AL(d3, d2), HY_AL(d4, d3)};
        *(u32x4*)(lds + 2 * HY_CPY + tid * 16) = (u32x4){d1, d2, d3, d4};
        *(u32x4*)(lds + 3 * HY_CPY + tid * 16) = (u32x4){HY_AL(d2, d1), HY_AL(d3, d2), HY_AL(d4, d3), HY_AL(d5, d4)};
        *(u32x4*)(lds + 4 * HY_CPY + tid * 16) = (u32x4){d2, d3, d4, d5};
        *(u32x4*)(lds + 5 * HY_CPY + tid * 16) = (u32x4){HY_AL(d3, d2), HY_AL(d4, d3), HY_AL(d5, d4), HY_AL(d6, d5)};
        *(u32x4*)(lds + 6 * HY_CPY + tid * 16) = (u32x4){d3, d4, d5, d6};
        *(u32x4*)(lds + 7 * HY_CPY + tid * 16) = (u32x4){HY_AL(d4, d3), HY_AL(d5, d4), HY_AL(d6, d5), HY_AL(d7, d6)};
#undef HY_AL
    }
    {
        const int cx = 1024 + c, cv = 2048 + c;
        const float xw0 = cw[cx], xw1 = cw[3072 + cx], xw2 = cw[6144 + cx], xb = cb[cx];
        const float vw0 = cw[cv], vw1 = cw[3072 + cv], vw2 = cw[6144 + cv], vb = cb[cv];
        const bf16_t* X2 = UT + (size_t)cx * TOK; const bf16_t* V = UT + (size_t)cv * TOK;
        for (int it = 0; it < 8; ++it) {
            const int ch = it * NTHR + tid, b = ch >> 8, s8 = (ch & 255) * 8; const size_t g0 = (size_t)b * SEQ + s8;
            const u32x4 xr = *(const u32x4*)(X2 + g0), vr = *(const u32x4*)(V + g0);
            float xe[10], ve[10];
            xe[0] = s8 > 0 ? bf2f(X2[g0 - 1]) : 0.f; ve[0] = s8 > 0 ? bf2f(V[g0 - 1]) : 0.f;
            xe[9] = s8 + 8 < SEQ ? bf2f(X2[g0 + 8]) : 0.f; ve[9] = s8 + 8 < SEQ ? bf2f(V[g0 + 8]) : 0.f;
#pragma unroll
            for (int e = 0; e < 4; ++e) { xe[1 + 2 * e] = bflo(xr[e]); xe[2 + 2 * e] = bfhi(xr[e]); ve[1 + 2 * e] = bflo(vr[e]); ve[2 + 2 * e] = bfhi(vr[e]); }
            float wv[8];
#pragma unroll
            for (int e = 0; e < 8; ++e) wv[e] = conv3(xe[e], xe[e + 1], xe[e + 2], xw0, xw1, xw2, xb) * conv3(ve[e], ve[e + 1], ve[e + 2], vw0, vw1, vw2, vb);
            u32x4 w;
#pragma unroll
            for (int e = 0; e < 4; ++e) w[e] = cvt_pk_bf16(wv[2 * e], wv[2 * e + 1]);
            *(u32x4*)(lds + HY_WOFF + b * HY_WROW + s8 * 2) = w;
        }
    }
    __syncthreads();
    const int m = lane & 15, kg = lane >> 4, jc = (7 - m) & 7;
    const int abase = jc * HY_CPY + (2047 - m - jc + 8 * kg) * 2;
    const int bbase = HY_WOFF + m * HY_WROW + kg * 16;
    const float x1w0 = cw[c], x1w1 = cw[3072 + c], x1w2 = cw[6144 + c], x1b = cb[c], hbias = p.in[I_HYBIAS][c];
    const bf16_t* X1 = UT + (size_t)c * TOK + (size_t)m * SEQ;
    for (int pq = 0; pq < 4; ++pq) {
        const int t00 = 64 * (wid + 8 * pq);
        f32x4 acc0 = {0.f, 0.f, 0.f, 0.f}, acc1 = acc0, acc2 = acc0, acc3 = acc0;
        const char* ap = lds + abase - 2 * t00;
        bf16x8 P2 = *(const bf16x8*)(ap - 64), P3 = *(const bf16x8*)(ap - 96);
        for (int ss = 0; ss < 64; ss += 2) {
            const int s0 = 32 * ss;
            const bf16x8 Bf = *(const bf16x8*)(lds + bbase + 2 * s0);
            const bf16x8 A0 = *(const bf16x8*)(ap + 2 * s0), A1 = *(const bf16x8*)(ap + 2 * s0 - 32);
            acc0 = __builtin_amdgcn_mfma_f32_16x16x32_bf16(A0, Bf, acc0, 0, 0, 0);
            acc1 = __builtin_amdgcn_mfma_f32_16x16x32_bf16(A1, Bf, acc1, 0, 0, 0);
            acc2 = __builtin_amdgcn_mfma_f32_16x16x32_bf16(P2, Bf, acc2, 0, 0, 0);
            acc3 = __builtin_amdgcn_mfma_f32_16x16x32_bf16(P3, Bf, acc3, 0, 0, 0);
            const bf16x8 Bg = *(const bf16x8*)(lds + bbase + 2 * s0 + 64);
            const bf16x8 Q0 = *(const bf16x8*)(ap + 2 * s0 + 64), Q1 = *(const bf16x8*)(ap + 2 * s0 + 32);
            acc0 = __builtin_amdgcn_mfma_f32_16x16x32_bf16(Q0, Bg, acc0, 0, 0, 0);
            acc1 = __builtin_amdgcn_mfma_f32_16x16x32_bf16(Q1, Bg, acc1, 0, 0, 0);
            acc2 = __builtin_amdgcn_mfma_f32_16x16x32_bf16(A0, Bg, acc2, 0, 0, 0);
            acc3 = __builtin_amdgcn_mfma_f32_16x16x32_bf16(A1, Bg, acc3, 0, 0, 0);
            P2 = Q0; P3 = Q1;
        }
#define HY_EPI(ACC, I) do { const int t = t00 + 16 * (I) + 4 * kg;                                                    \
            const u32x2 wr2 = *(const u32x2*)(lds + HY_WOFF + m * HY_WROW + t * 2);                                    \
            const u32x2 xr2 = *(const u32x2*)(X1 + t);                                                                \
            const float xm = t > 0 ? bf2f(X1[t - 1]) : 0.f, xp = t + 4 < SEQ ? bf2f(X1[t + 4]) : 0.f;                   \
            const float x0 = bflo(xr2[0]), x1 = bfhi(xr2[0]), x2 = bflo(xr2[1]), x3 = bfhi(xr2[1]);                    \
            const float o0 = (ACC[0] + bflo(wr2[0]) * hbias) * conv3(xm, x0, x1, x1w0, x1w1, x1w2, x1b);               \
            const float o1 = (ACC[1] + bfhi(wr2[0]) * hbias) * conv3(x0, x1, x2, x1w0, x1w1, x1w2, x1b);               \
            const float o2 = (ACC[2] + bflo(wr2[1]) * hbias) * conv3(x1, x2, x3, x1w0, x1w1, x1w2, x1b);               \
            const float o3 = (ACC[3] + bfhi(wr2[1]) * hbias) * conv3(x2, x3, xp, x1w0, x1w1, x1w2, x1b);               \
            u32x2 ow; ow.x = cvt_pk_bf16(o0, o1); ow.y = cvt_pk_bf16(o2, o3);                                          \
            *(u32x2*)(OAT + (size_t)c * TOK + (size_t)m * SEQ + t) = ow; } while (0)
        HY_EPI(acc0, 0); HY_EPI(acc1, 1); HY_EPI(acc2, 2); HY_EPI(acc3, 3);
#undef HY_EPI
    }
}

constexpr int HG_QE = 0, HG_KE = 17408, HG_KET = 34816, HG_VT = 53248, HG_ATT = 71680, HG_BL = 80896, HG_SEG = 81408;
DI void hgrn_item(PPtr pp, int item, char* lds) {
    const int tid = otid(), wid = tid >> 6, lane = tid & 63, m = lane & 15, kg = lane >> 4;
    const int dir = item & 1, bh = item >> 1, b = bh >> 3, h = bh & 7;
    const bf16_t* base = (const bf16_t*)(p.ws + WS_P) + (size_t)b * SEQ * ODD_IN;
    bf16_t* OD = (dir ? (bf16_t*)(p.ws + WS_OB) : (bf16_t*)(p.ws + WS_P + P_OF)) + (size_t)b * SEQ * 1024 + h * 128;
    const int kq = tid & 31, ts = tid >> 5;
    const int col_q = h * 128 + 4 * kq, col_f = 1024 * (1 + dir) + h * 128 + 4 * kq, col_v = 3072 + h * 128 + 4 * kq;
    float lb[4];
    { const float* lg = p.in[I_LBLOG] + (size_t)dir * 2 * 1024 + h * 128 + 4 * kq;
#pragma unroll
      for (int e = 0; e < 4; ++e) lb[e] = 1.f / (1.f + __expf(lg[e] - lg[1024 + e])); }
    f32x4 S[8];
#pragma unroll
    for (int i = 0; i < 8; ++i) S[i] = (f32x4){0.f, 0.f, 0.f, 0.f};
    u32x2 rq[4], rf[4], rv[4];
#define HG_LOAD(cc) do { _Pragma("unroll") for (int i = 0; i < 4; ++i) { const int t = (cc) * 64 + 4 * ts + i; const int pos = dir ? (SEQ - 1 - t) : t; \
        const bf16_t* row = base + (size_t)pos * ODD_IN; rq[i] = *(const u32x2*)(row + col_q); rf[i] = *(const u32x2*)(row + col_f); rv[i] = *(const u32x2*)(row + col_v); } } while (0)
    __syncthreads();
    HG_LOAD(0);
    float* SEG = (float*)(lds + HG_SEG); float* BL = (float*)(lds + HG_BL);
    for (int c = 0; c < 32; ++c) {
        float q[4][4], kk[4][4], cs[4][4];
#pragma unroll
        for (int i = 0; i < 4; ++i) {
            const float fz[4] = {bflo(rf[i][0]), bfhi(rf[i][0]), bflo(rf[i][1]), bfhi(rf[i][1])};
            q[i][0] = bflo(rq[i][0]); q[i][1] = bfhi(rq[i][0]); q[i][2] = bflo(rq[i][1]); q[i][3] = bfhi(rq[i][1]);
#pragma unroll
            for (int e = 0; e < 4; ++e) { const float sg = __builtin_amdgcn_rcpf(1.f + __expf(-fz[e])); const float f = lb[e] + (1.f - lb[e]) * sg;
                kk[i][e] = 1.f - f; cs[i][e] = (i == 0) ? f : cs[i - 1][e] * f; }
        }
        *(f32x4*)(SEG + ts * 128 + 4 * kq) = (f32x4){cs[3][0], cs[3][1], cs[3][2], cs[3][3]};
        const u32x2 v0 = rv[0], v1 = rv[1], v2 = rv[2], v3 = rv[3];
        __syncthreads();
        f32x4 off = {1.f, 1.f, 1.f, 1.f}, tot = {1.f, 1.f, 1.f, 1.f};
#pragma unroll
        for (int s = 0; s < 16; ++s) { const f32x4 sv = *(const f32x4*)(SEG + s * 128 + 4 * kq); tot *= sv; if (s < ts) off *= sv; }
        float ke[4][4], qe[4][4];
#pragma unroll
        for (int i = 0; i < 4; ++i)
#pragma unroll
            for (int e = 0; e < 4; ++e) { const float eb = cs[i][e] * off[e]; qe[i][e] = q[i][e] * 0.08838834764831845f * eb; ke[i][e] = kk[i][e] * __builtin_amdgcn_rcpf(eb); }
#pragma unroll
        for (int i = 0; i < 4; ++i) { const int t = 4 * ts + i;
            *(u32x2*)(lds + HG_QE + t * 272 + 8 * kq) = (u32x2){cvt_pk_bf16(qe[i][0], qe[i][1]), cvt_pk_bf16(qe[i][2], qe[i][3])};
            *(u32x2*)(lds + HG_KE + t * 272 + 8 * kq) = (u32x2){cvt_pk_bf16(ke[i][0], ke[i][1]), cvt_pk_bf16(ke[i][2], ke[i][3])}; }
#pragma unroll
        for (int e = 0; e < 4; ++e) {
            *(u32x2*)(lds + HG_KET + (4 * kq + e) * 144 + 8 * ts) = (u32x2){cvt_pk_bf16(ke[0][e], ke[1][e]), cvt_pk_bf16(ke[2][e], ke[3][e])};
            const unsigned a0 = (e & 1) ? (v0[e >> 1] >> 16) : (v0[e >> 1] & 0xffffu), a1 = (e & 1) ? (v1[e >> 1] >> 16) : (v1[e >> 1] & 0xffffu);
            const unsigned a2 = (e & 1) ? (v2[e >> 1] >> 16) : (v2[e >> 1] & 0xffffu), a3 = (e & 1) ? (v3[e >> 1] >> 16) : (v3[e >> 1] & 0xffffu);
            *(u32x2*)(lds + HG_VT + (4 * kq + e) * 144 + 8 * ts) = (u32x2){a0 | (a1 << 16), a2 | (a3 << 16)};
        }
        if (ts == 0) *(f32x4*)(BL + 4 * kq) = tot;
        if (c + 1 < 32) HG_LOAD(c + 1);
        __syncthreads();
        {
            const int ib = wid >> 1;
#pragma unroll
            for (int j2 = 0; j2 < 2; ++j2) {
                const int jb = (wid & 1) * 2 + j2;
                f32x4 a = {0.f, 0.f, 0.f, 0.f};
                if (jb <= ib) {
#pragma unroll
                    for (int k4 = 0; k4 < 4; ++k4) {
                        const bf16x8 Af = *(const bf16x8*)(lds + HG_QE + (16 * ib + m) * 272 + (32 * k4 + 8 * kg) * 2);
                        const bf16x8 Bf = *(const bf16x8*)(lds + HG_KE + (16 * jb + m) * 272 + (32 * k4 + 8 * kg) * 2);
                        a = __builtin_amdgcn_mfma_f32_16x16x32_bf16(Af, Bf, a, 0, 0, 0);
                    }
                }
                const int s = 16 * jb + m;
#pragma unroll
                for (int r = 0; r < 4; ++r) { const int t = 16 * ib + 4 * kg + r; const float v = (jb <= ib && s <= t) ? a[r] : 0.f;
                    *(bf16_t*)(lds + HG_ATT + t * 144 + s * 2) = f2bf_c(v); }
            }
        }
        __syncthreads();
        {
            bf16x8 Sb[4];
#pragma unroll
            for (int k4 = 0; k4 < 4; ++k4) { u32x4 w; w[0] = cvt_pk_bf16(S[2 * k4][0], S[2 * k4][1]); w[1] = cvt_pk_bf16(S[2 * k4][2], S[2 * k4][3]);
                w[2] = cvt_pk_bf16(S[2 * k4 + 1][0], S[2 * k4 + 1][1]); w[3] = cvt_pk_bf16(S[2 * k4 + 1][2], S[2 * k4 + 1][3]); Sb[k4] = *reinterpret_cast<bf16x8*>(&w); }
            const bf16x8 Bv0 = *(const bf16x8*)(lds + HG_VT + (16 * wid + m) * 144 + (8 * kg) * 2);
            const bf16x8 Bv1 = *(const bf16x8*)(lds + HG_VT + (16 * wid + m) * 144 + (32 + 8 * kg) * 2);
#pragma unroll
            for (int ib = 0; ib < 4; ++ib) {
                f32x4 a = {0.f, 0.f, 0.f, 0.f};
                { const bf16x8 Af = *(const bf16x8*)(lds + HG_ATT + (16 * ib + m) * 144 + (8 * kg) * 2); a = __builtin_amdgcn_mfma_f32_16x16x32_bf16(Af, Bv0, a, 0, 0, 0); }
                if (ib >= 2) { const bf16x8 Af = *(const bf16x8*)(lds + HG_ATT + (16 * ib + m) * 144 + (32 + 8 * kg) * 2); a = __builtin_amdgcn_mfma_f32_16x16x32_bf16(Af, Bv1, a, 0, 0, 0); }
#pragma unroll
                for (int k4 = 0; k4 < 4; ++k4) {
                    const u32x2 lo = *(const u32x2*)(lds + HG_QE + (16 * ib + m) * 272 + (32 * k4 + 4 * kg) * 2);
                    const u32x2 hi2 = *(const u32x2*)(lds + HG_QE + (16 * ib + m) * 272 + (32 * k4 + 16 + 4 * kg) * 2);
                    u32x4 w = {lo[0], lo[1], hi2[0], hi2[1]};
                    a = __builtin_amdgcn_mfma_f32_16x16x32_bf16(*reinterpret_cast<bf16x8*>(&w), Sb[k4], a, 0, 0, 0);
                }
#pragma unroll
                for (int r = 0; r < 4; ++r) { const int t = c * 64 + 16 * ib + 4 * kg + r; const int pos = dir ? (SEQ - 1 - t) : t;
                    OD[(size_t)pos * 1024 + 16 * wid + m] = f2bf_c(a[r]); }
            }
#pragma unroll
            for (int kb = 0; kb < 8; ++kb) {
                const bf16x8 A0 = *(const bf16x8*)(lds + HG_KET + (16 * kb + m) * 144 + (8 * kg) * 2);
                const bf16x8 A1 = *(const bf16x8*)(lds + HG_KET + (16 * kb + m) * 144 + (32 + 8 * kg) * 2);
                S[kb] = __builtin_amdgcn_mfma_f32_16x16x32_bf16(A0, Bv0, S[kb], 0, 0, 0);
                S[kb] = __builtin_amdgcn_mfma_f32_16x16x32_bf16(A1, Bv1, S[kb], 0, 0, 0);
                const f32x4 bl = *(const f32x4*)(BL + 16 * kb + 4 * kg);
                S[kb] *= bl;
            }
        }
    }
#undef HG_LOAD
}

#undef p

#define XB_TMO      128
#define XB_XCNT(j)  (256  + 64 * (j))
#define XB_XSUB(j)  (1280 + 64 * (j))
#define XB_XGEN(j)  (2304 + 64 * (j))
#define XB_TOP      3328
#define XB_TOPGEN   3392
#define XCD_BAR_WORDS 3456
#define XB_SPIN_CAP (1u << 22)
DI unsigned xb_ld(unsigned* p)              { return __hip_atomic_load(p, __ATOMIC_RELAXED, __HIP_MEMORY_SCOPE_AGENT); }
DI unsigned xb_add(unsigned* p, unsigned v) { return __hip_atomic_fetch_add(p, v, __ATOMIC_RELAXED, __HIP_MEMORY_SCOPE_AGENT); }
DI unsigned xb_xcc_id() { return (unsigned)__builtin_amdgcn_s_getreg((3 << 11) | 20) & 0xFu; }
#define XB_SPIN(cond, bar) do { unsigned _sp = 0; while (cond) { __builtin_amdgcn_s_sleep(1); \
    if ((++_sp & 255u) == 0u) { if (xb_ld(&(bar)[XB_TMO])) break; if (_sp > XB_SPIN_CAP) { atomicAdd(&(bar)[XB_TMO], 1u); break; } } } } while (0)
struct XcdBarrier { unsigned* bar; unsigned x; volatile LAS unsigned* st; };
DI XcdBarrier xcd_barrier_post(unsigned* bar, volatile LAS unsigned* st) {
    XcdBarrier b; b.bar = bar; b.x = xb_xcc_id(); b.st = st;
    if (threadIdx.x == 0) (void)xb_add(&bar[XB_XCNT(b.x)], 1u);
    return b;
}
DI void xcd_barrier_complete(unsigned* bar, unsigned x, unsigned& nloc, unsigned& nx) {
    const unsigned G = gridDim.x * gridDim.y * gridDim.z;
    unsigned sum, cnt, mine, sp = 0u;
    for (;;) {
        sum = 0u; cnt = 0u; mine = 0u;
#pragma unroll
        for (unsigned j = 0; j < 16; ++j) { const unsigned c = xb_ld(&bar[XB_XCNT(j)]); sum += c; cnt += (c > 0u) ? 1u : 0u; mine = (j == x) ? c : mine; }
        if (sum == G) break;
        __builtin_amdgcn_s_sleep(1);
        if ((++sp & 255u) == 0u) { if (xb_ld(&bar[XB_TMO])) break; if (sp > XB_SPIN_CAP) { atomicAdd(&bar[XB_TMO], 1u); break; } }
    }
    nloc = mine > 0u ? mine : 1u; nx = cnt > 0u ? cnt : 1u;
}
DI void xcd_barrier(const XcdBarrier& b) {
    asm volatile("s_waitcnt vmcnt(0)" ::: "memory");
    __syncthreads();
    if (threadIdx.x == 0) {
        unsigned* bar = b.bar;
        __builtin_amdgcn_s_waitcnt(0);
        unsigned nloc = b.st[0], nx = b.st[1];
        if (nloc == 0u) { xcd_barrier_complete(bar, b.x, nloc, nx); b.st[0] = nloc; b.st[1] = nx; }
        const unsigned old = xb_add(&bar[XB_XSUB(b.x)], 1u);
        const unsigned gen = old / nloc;
        if (old + 1u == (gen + 1u) * nloc) {
            __builtin_amdgcn_fence(__ATOMIC_RELEASE, "agent");
            asm volatile("s_waitcnt vmcnt(0)" ::: "memory");
            const unsigned og = xb_add(&bar[XB_TOP], 1u);
            const unsigned tg = og / nx;
            if (og + 1u == (tg + 1u) * nx) xb_add(&bar[XB_TOPGEN], 1u);
            else XB_SPIN(xb_ld(&bar[XB_TOPGEN]) == tg, bar);
            __builtin_amdgcn_fence(__ATOMIC_ACQUIRE, "agent");
            xb_add(&bar[XB_XGEN(b.x)], 1u);
            asm volatile("s_waitcnt vmcnt(0)" ::: "memory");
        } else {
            XB_SPIN(xb_ld(&bar[XB_XGEN(b.x)]) == gen, bar);
            __builtin_amdgcn_fence(__ATOMIC_ACQUIRE, "agent");
            asm volatile("s_waitcnt vmcnt(0)" ::: "memory");
        }
    }
    __syncthreads();
}
#define CGSYNC() do { __builtin_amdgcn_fence(__ATOMIC_RELEASE, "agent"); grid.sync(); __builtin_amdgcn_fence(__ATOMIC_ACQUIRE, "agent"); } while (0)
#define GSYNC() xcd_barrier(xb)
#define FRESH() PPtr pp = fresh_params(); unsigned char* ws = pp->ws; bf16_t* HB = (bf16_t*)(ws + WS_HB); bf16_t* PB = (bf16_t*)(ws + WS_P); float* R = pp->out; (void)HB; (void)PB; (void)R
__global__ void __launch_bounds__(NTHR) fwd_megakernel(Params p_unused) {
    extern __shared__ __attribute__((aligned(16))) unsigned char lds[];
    cg::grid_group grid = cg::this_grid();
    const int G = gridDim.x, bid = blockIdx.x;
    volatile LAS unsigned* xst = (volatile LAS unsigned*)((LAS unsigned char*)lds + (LDS_BYTES - 16));
    if (threadIdx.x == 0) { xst[0] = 0u; xst[1] = 0u; }
    __syncthreads();
    XcdBarrier xb;
    if (bid == 0) { PPtr pq = fresh_params(); unsigned* bw = (unsigned*)(pq->ws + WS_BAR);
        for (int i = otid(); i < 4096; i += NTHR) bw[i] = 0u; }

    {
        FRESH();
        xpose_w(pp->in[I_EVWIN], (bf16_t*)(ws + WS_WIN0), DM, EVEN_IN, (float*)lds);
        xpose_w(pp->in[I_ODWIN], (bf16_t*)(ws + WS_WIN1), DM, ODD_IN, (float*)lds, pp->in[I_NMIX] + DM);
        xpose_w(pp->in[I_EVWOUT], (bf16_t*)(ws + WS_WOUT), DM, DM, (float*)lds);
        xpose_w(pp->in[I_ODWOUT], (bf16_t*)(ws + WS_WOUT + SZ_WOUT), DM, DM, (float*)lds);
#pragma unroll 1
        for (int l = 0; l < 2; ++l) {
            xpose_w(pp->in[I_CAWQ] + (size_t)l * DM * CAW, (bf16_t*)(ws + WS_CAQ + l * SZ_CAQ), DM, CAW, (float*)lds, pp->in[I_NMQ] + l * DM);
            xpose_w(pp->in[I_CAWKV] + (size_t)l * DM * 2 * CAW, (bf16_t*)(ws + WS_CAKV + l * SZ_CAKV), DM, 2 * CAW, (float*)lds);
            xpose_w(pp->in[I_CAWO] + (size_t)l * CAW * DM, (bf16_t*)(ws + WS_CAO + l * SZ_CAO), CAW, DM, (float*)lds);
            xpose_w(pp->in[I_W1] + (size_t)l * DM * FFN, (bf16_t*)(ws + WS_W1 + l * SZ_W1), DM, FFN, (float*)lds, pp->in[I_NFFN] + l * DM);
            xpose_w(pp->in[I_W2] + (size_t)l * FFN * DM, (bf16_t*)(ws + WS_W2 + l * SZ_W1), FFN, DM, (float*)lds);
            rmsnorm_rows(pp->in[I_MEM], pp->in[I_NMKV] + l * DM, (bf16_t*)(ws + WS_MEMN + l * SZ_MEMN), MTOK);
        }
        { const int idx = bid * NTHR + otid();
          if (idx < 64 * 32) { const int pc = idx >> 5, ii = idx & 31; const float inv = exp2f(-(float)ii * (13.287712379549449f / 32.f));
              float sn, cs; sincosf((float)pc * inv, &sn, &cs); ((f32x2*)(ws + WS_ROPE))[idx] = (f32x2){cs, sn}; } }
        __syncthreads();
        hyena_filters(pp, (float*)lds);
        rmsnorm_rows(pp->in[I_X], pp->in[I_NMIX], HB, TOK);
    }
    CGSYNC();
    { PPtr pq = fresh_params(); xb = xcd_barrier_post((unsigned*)(pq->ws + WS_BAR), xst); }

#pragma unroll 1
    for (int layer = 0; layer < 2; ++layer) {
        if (layer == 0) {
            {
                FRESH();
                { pg8::EpiBf16<0> E{PB + P_UT / 2, TOK, nullptr}; run_gemm(lds, (const bf16_t*)(ws + WS_WIN0), HB, 3072, TOK, DM, E, 0); }
                { pg8::EpiBf16<0> E{PB + P_QKV0 / 2, 3072, nullptr}; run_gemm(lds, HB, (const bf16_t*)(ws + WS_WIN0) + (size_t)3072 * DM, TOK, 3072, DM, E, 0); }
                asm volatile("s_waitcnt vmcnt(0)" ::: "memory");
                __syncthreads();
                {
                    pg8::StaticOrder S; S.init(TOK, 3072, G, bid); pg8::Unit u;
#pragma unroll 1
                    for (int ui = 0; S.next(ui, u); ++ui)
                        if (u.pn < 8) groupnorm_tile<64>(PB + P_QKV0 / 2, 3072, u.pm * 256, u.pn * 256, u.pn < 4 ? pp->in[I_DFQG] : pp->in[I_DFKG]);
                }
#pragma unroll 1
                for (int l = 0; l < 2; ++l) { pg8::EpiBf16<0> E{(bf16_t*)(ws + WS_KV + l * SZ_KV), 1024, nullptr};
                    run_gemm(lds, (const bf16_t*)(ws + WS_MEMN + l * SZ_MEMN), (const bf16_t*)(ws + WS_CAKV + l * SZ_CAKV), MTOK, 1024, DM, E, 64 * l);
                    asm volatile("s_waitcnt vmcnt(0)" ::: "memory");
                    __syncthreads();
                    pg8::StaticOrder S; S.init(MTOK, 1024, G, (bid + 64 * l) % G); pg8::Unit u;
#pragma unroll 1
                    for (int ui = 0; S.next(ui, u); ++ui)
                        if (u.pn < 2) groupnorm_tile<128>((bf16_t*)(ws + WS_KV + l * SZ_KV), 1024, u.pm * 256, u.pn * 256, pp->in[I_CAKG] + l * 128);
                }
            }
            GSYNC();
            {
                FRESH();
#pragma unroll 1
                for (int c = bid; c < 1024; c += G) hyena_item(pp, c, (char*)lds);
            }
            {
                FRESH();
                float lam;
                { const int lane = otid() & 63; float a = pp->in[I_LQ1][lane] * pp->in[I_LK1][lane], b2 = pp->in[I_LQ2][lane] * pp->in[I_LK2][lane];
                  a = wave_sum(a); b2 = wave_sum(b2); lam = __expf(a) - __expf(b2) + 0.2f; }
                float dcut;
                { const int lane = otid() & 63; float gq = fabsf(pp->in[I_DFQG][lane]), gk = fabsf(pp->in[I_DFKG][lane]);
#pragma unroll
                  for (int o = 32; o > 0; o >>= 1) { gq = fmaxf(gq, __shfl_xor(gq, o)); gk = fmaxf(gk, __shfl_xor(gk, o)); }
                  dcut = 104.f + 2.f * (8.f * gq * gk * 1.05f) + 1.f; }
                const bf16_t* QKV = PB + P_QKV0 / 2;
                float* scr = (float*)(ws + WS_P + P_SCR) + (size_t)bid * 32768;
                unsigned* qctr = (unsigned*)(ws + WS_BAR + 15360);
                volatile LAS unsigned* qslot = (volatile LAS unsigned*)((LAS unsigned char*)lds + (LDS_BYTES - 32));
#pragma unroll 1
                for (;;) {
                    __syncthreads();
                    if (threadIdx.x == 0) *qslot = __hip_atomic_fetch_add(qctr, 1u, __ATOMIC_RELAXED, __HIP_MEMORY_SCOPE_AGENT);
                    __syncthreads();
                    const int it = (int)__builtin_amdgcn_readfirstlane(*qslot);
                    if (it >= 1024) break;
                    const int qb = it & 7, h = 7 - (it >> 7), b = (it >> 3) & 15;
                    const size_t tok0 = (size_t)b * SEQ + qb * 256;
                    const float slope = exp2f(-(float)(h + 1)), slope2 = slope * LOG2E;
                    int kt_lo, ntile;
                    { const int dk = (int)fminf(dcut / slope + 1.f, 4096.f);
                      int lo = (qb * 256 - dk) >> 6, hi = (qb * 256 + 255 + dk) >> 6; lo = lo < 0 ? 0 : lo; hi = hi > 31 ? 31 : hi;
                      if (((hi - lo + 1) & 1) != 0) { if (lo > 0) --lo; else ++hi; }
                      kt_lo = __builtin_amdgcn_readfirstlane(lo); ntile = __builtin_amdgcn_readfirstlane(hi - lo + 1); }
                    f32x16 o[4];
#pragma unroll 1
                    for (int mp = 0; mp < 2; ++mp) {
                        __syncthreads();
                        attn_core<64, true, false>(QKV + tok0 * 3072 + h * 128 + mp * 64, 3072, QKV + ((size_t)b * SEQ + kt_lo * 64) * 3072 + 1024 + h * 128 + mp * 64, 3072,
                                                   QKV + ((size_t)b * SEQ + kt_lo * 64) * 3072 + 2048 + h * 128, 3072, ntile * 64, (char*)lds, 0.125f * LOG2E, slope2, qb * 256 - kt_lo * 64, nullptr, o);
                        if (mp == 0) {
                            float* sp = scr + otid() * 64;
#pragma unroll
                            for (int d = 0; d < 4; ++d)
#pragma unroll
                                for (int r = 0; r < 16; r += 4) *(f32x4*)(sp + d * 16 + r) = (f32x4){o[d][r], o[d][r + 1], o[d][r + 2], o[d][r + 3]};
                        }
                    }
                    const int tid2 = otid(), r32 = tid2 & 31;
                    const float* subg = launder(pp->in[I_SUBLN]);
                    const float* sp = scr + tid2 * 64;
                    float ssq[16];
#pragma unroll
                    for (int r = 0; r < 16; ++r) ssq[r] = 0.f;
#pragma unroll
                    for (int d = 0; d < 4; ++d)
#pragma unroll
                        for (int r = 0; r < 16; r += 4) { const f32x4 s4 = *(const f32x4*)(sp + d * 16 + r);
#pragma unroll
                            for (int e = 0; e < 4; ++e) { const float v = s4[e] - lam * o[d][r + e]; o[d][r + e] = v; ssq[r + e] += v * v; } }
#pragma unroll
                    for (int r = 0; r < 16; ++r) {
#pragma unroll
                        for (int x = 1; x < 32; x <<= 1) ssq[r] += __shfl_xor(ssq[r], x);
                        const float sc = rsqrtf(ssq[r] * (1.f / 128) + EPS) * 0.8f;
#pragma unroll
                        for (int d = 0; d < 4; ++d) o[d][r] *= sc * subg[d * 32 + r32];
                    }
                    store_o_bf16(o, HB + tok0 * DM + 1024 + h * 128, DM);
                }
            }
            GSYNC();
            { FRESH(); xpose_oat(PB + P_OAT / 2, HB, (bf16_t*)lds); }
            GSYNC();
        } else {
            {
                FRESH();
                { pg8::EpiBf16<0, true> E{PB, ODD_IN, (const float*)(ws + WS_SSQ)}; run_gemm(lds, HB, (const bf16_t*)(ws + WS_WIN1), TOK, ODD_IN, DM, E, 0); }
                asm volatile("s_waitcnt vmcnt(0)" ::: "memory");
                __syncthreads();
                pg8::StaticOrder S; S.init(TOK, ODD_IN, G, bid); pg8::Unit u;
#pragma unroll 1
                for (int ui = 0; S.next(ui, u); ++ui)
                    if (u.pn >= 20 && u.pn < 25) gqa_prep_tile(PB, u.pm * 256, u.pn * 256, u.pn < 24 ? pp->in[I_GQQG] : pp->in[I_GQKG], (const f32x2*)(ws + WS_ROPE));
            }
            GSYNC();
            {
                FRESH();
#pragma unroll 1
                for (int it = bid; it < 256; it += G) hgrn_item(pp, it, (char*)lds);
            }
            {
                FRESH();
#pragma unroll 1
                for (int it = bid; it < 1024; it += G) {
                    const int qb = it & 7, h = (it >> 3) & 7, b = it >> 6;
                    const size_t tok0 = (size_t)b * SEQ + qb * 256;
                    f32x16 o[4];
                    __syncthreads();
                    attn_core<128, false, false>(PB + tok0 * ODD_IN + 5120 + h * 128, ODD_IN, PB + (size_t)b * SEQ * ODD_IN + 6144 + (h >> 2) * 128, ODD_IN,
                                                 PB + (size_t)b * SEQ * ODD_IN + 6400 + (h >> 2) * 128, ODD_IN, SEQ, (char*)lds, 0.08838834764831845f * LOG2E, 0.f, 0, nullptr, o);
                    store_o_bf16(o, HB + tok0 * DM + 1024 + h * 128, DM);
                }
            }
            GSYNC();
            { FRESH(); hgrn_post(PB + P_OF / 2, (const bf16_t*)(ws + WS_OB), PB, pp->in[I_HGNG], HB); }
            GSYNC();
        }
        { FRESH(); pg8::EpiResNorm E{layer == 0 ? pp->in[I_X] : R, R, PB + P_XB / 2, (float*)(ws + WS_SSQ), DM}; run_gemm(lds, HB, (const bf16_t*)(ws + WS_WOUT + layer * SZ_WOUT), TOK, DM, DM, E, 0, 4); }
        GSYNC();
        { FRESH(); pg8::EpiBf16<0, true> E{PB + P_QC / 2, CAW, (const float*)(ws + WS_SSQ)}; run_gemm(lds, PB + P_XB / 2, (const bf16_t*)(ws + WS_CAQ + layer * SZ_CAQ), TOK, CAW, DM, E, 0); }
        asm volatile("s_waitcnt vmcnt(0)" ::: "memory");
        __syncthreads();
        {
            FRESH();
            const bf16_t* KV = (const bf16_t*)(ws + WS_KV + layer * SZ_KV);
            pg8::StaticOrder S; S.init(TOK, CAW, G, bid);
            pg8::Unit u;
#pragma unroll 1
            for (int ui = 0; S.next(ui, u); ++ui) {
#pragma unroll 1
                for (int hh = 0; hh < 2; ++hh) {
                    const int h = 2 * u.pn + hh, b = u.pm >> 3;
                    const size_t tok0 = (size_t)u.pm * 256;
                    f32x16 o[4];
                    __syncthreads();
                    attn_core<128, false, true>(PB + P_QC / 2 + tok0 * CAW + h * 128, CAW, KV + (size_t)b * 256 * 1024 + h * 128, 1024,
                                                KV + (size_t)b * 256 * 1024 + 512 + h * 128, 1024, 256, (char*)lds, 0.08838834764831845f * LOG2E, 0.f, 0, pp->in[I_CAQG] + layer * 128, o);
                    store_o_bf16(o, PB + P_OC / 2 + tok0 * CAW + h * 128, CAW);
                }
            }
        }
        GSYNC();
        { FRESH(); pg8::EpiResNorm E{R, R, HB, (float*)(ws + WS_SSQ), DM}; run_gemm(lds, PB + P_OC / 2, (const bf16_t*)(ws + WS_CAO + layer * SZ_CAO), TOK, DM, CAW, E, 0, 4); }
        GSYNC();
        { FRESH(); pg8::EpiBf16<1, true> E{PB, FFN, (const float*)(ws + WS_SSQ)}; run_gemm(lds, HB, (const bf16_t*)(ws + WS_W1 + layer * SZ_W1), TOK, FFN, DM, E, 0); }
        GSYNC();
        if (layer == 0) { FRESH(); pg8::EpiResNorm E{R, R, HB, (float*)(ws + WS_SSQ), DM}; run_gemm(lds, PB, (const bf16_t*)(ws + WS_W2 + layer * SZ_W1), TOK, DM, FFN, E, 0, 4); }
        else { FRESH(); pg8::EpiResF32 E{R, R, DM}; run_gemm(lds, PB, (const bf16_t*)(ws + WS_W2 + layer * SZ_W1), TOK, DM, FFN, E, 0, 4); }
        GSYNC();
    }
}

extern "C" void kernel_launch(void* const* d_in, const int* in_sizes, int n_in, void* d_out, int out_size, void* d_ws, size_t ws_size, hipStream_t stream) {
    static int grid_blocks = 0;
    if (grid_blocks == 0) {
        if (n_in != 39 || ws_size < WS_END) { fprintf(stderr, "kernel_launch: unexpected n_in %d / ws %zu (need %zu)\n", n_in, ws_size, (size_t)WS_END); grid_blocks = -1; return; }
        int dev = 0, cus = 0, per_cu = 0;
        hipGetDevice(&dev);
        hipDeviceGetAttribute(&cus, hipDeviceAttributeMultiprocessorCount, dev);
        if (hipFuncSetAttribute((const void*)fwd_megakernel, hipFuncAttributeMaxDynamicSharedMemorySize, LDS_BYTES) != hipSuccess) { fprintf(stderr, "kernel_launch: hipFuncSetAttribute failed\n"); grid_blocks = -1; return; }
        hipOccupancyMaxActiveBlocksPerMultiprocessor(&per_cu, (const void*)fwd_megakernel, NTHR, LDS_BYTES);
        if (per_cu < 1) per_cu = 1;
        grid_blocks = cus * per_cu;
    }
    if (grid_blocks < 0) return;
    Params p{};
    for (int i = 0; i < 39; ++i) p.in[i] = (const float*)d_in[i];
    p.out = (float*)d_out; p.ws = (unsigned char*)d_ws;
    void* args[] = {&p};
    hipError_t e = hipLaunchCooperativeKernel((const void*)fwd_megakernel, dim3(grid_blocks), dim3(NTHR), args, LDS_BYTES, stream);
    if (e != hipSuccess) fprintf(stderr, "cooperative launch failed: %s (grid %d)\n", hipGetErrorString(e), grid_blocks);
}
```

```cpp
#include <hip/hip_runtime.h>
#include <hip/hip_cooperative_groups.h>
#include <cstdio>
#include <cstdint>
namespace cg = cooperative_groups;

#define DI __device__ __forceinline__
#define LAS __attribute__((address_space(3)))
typedef unsigned short bf16_t;
typedef short bf16x8 __attribute__((ext_vector_type(8)));
typedef short s16x4 __attribute__((ext_vector_type(4)));
typedef float f32x2 __attribute__((ext_vector_type(2)));
typedef float f32x4 __attribute__((ext_vector_type(4)));
typedef float f32x16 __attribute__((ext_vector_type(16)));
typedef unsigned u32x2 __attribute__((ext_vector_type(2)));
typedef unsigned u32x4 __attribute__((ext_vector_type(4)));

constexpr int NTHR = 512;
constexpr int DM = 2048, SEQ = 2048, TOK = 32768, MTOK = 4096;
constexpr int EVEN_IN = 6144, ODD_IN = 6656, FFN = 8192, CAW = 512;
constexpr int LDS_BYTES = 136 * 1024;
constexpr float EPS = 1e-6f;
constexpr float LOG2E = 1.4426950408889634f;

constexpr size_t AL(size_t x) { return (x + 255) & ~(size_t)255; }
constexpr size_t WS_WIN0 = 0;
constexpr size_t WS_WIN1 = WS_WIN0 + AL((size_t)EVEN_IN * DM * 2);
constexpr size_t WS_WOUT = WS_WIN1 + AL((size_t)ODD_IN * DM * 2);
constexpr size_t SZ_WOUT = (size_t)DM * DM * 2;
constexpr size_t WS_CAQ = WS_WOUT + 2 * SZ_WOUT;
constexpr size_t SZ_CAQ = (size_t)CAW * DM * 2;
constexpr size_t WS_CAKV = WS_CAQ + 2 * SZ_CAQ;
constexpr size_t SZ_CAKV = (size_t)2 * CAW * DM * 2;
constexpr size_t WS_CAO = WS_CAKV + 2 * SZ_CAKV;
constexpr size_t SZ_CAO = (size_t)DM * CAW * 2;
constexpr size_t WS_W1 = WS_CAO + 2 * SZ_CAO;
constexpr size_t SZ_W1 = (size_t)FFN * DM * 2;
constexpr size_t WS_W2 = WS_W1 + 2 * SZ_W1;
constexpr size_t WS_P = WS_W2 + 2 * SZ_W1;
constexpr size_t SZ_P = (size_t)TOK * FFN * 2;
constexpr size_t WS_HB = WS_P + SZ_P;
constexpr size_t SZ_HB = (size_t)TOK * DM * 2;
constexpr size_t WS_OB = WS_HB + SZ_HB;
constexpr size_t SZ_OB = (size_t)TOK * 1024 * 2;
constexpr size_t WS_MEMN = WS_OB + SZ_OB;
constexpr size_t SZ_MEMN = (size_t)MTOK * DM * 2;
constexpr size_t WS_KV = WS_MEMN + 2 * SZ_MEMN;
constexpr size_t SZ_KV = (size_t)MTOK * 1024 * 2;
constexpr size_t WS_FILT = WS_KV + 2 * SZ_KV;
constexpr size_t WS_BAR = WS_FILT + (size_t)1024 * 4096 * 2;
constexpr size_t WS_SSQ = WS_BAR + 16384;
constexpr size_t WS_ROPE = WS_SSQ + (size_t)TOK * 32 * 4;
constexpr size_t WS_END = WS_ROPE + 64 * 32 * 8;
static_assert(WS_END <= (size_t)1073741824, "workspace budget");
constexpr size_t P_UT = 0;
constexpr size_t P_QKV0 = (size_t)3072 * TOK * 2;
constexpr size_t P_OAT = P_QKV0 + (size_t)TOK * 3072 * 2;
constexpr size_t P_SCR = P_OAT + (size_t)1024 * TOK * 2;
constexpr size_t P_XB = 0;
constexpr size_t P_QC = (size_t)TOK * DM * 2;
constexpr size_t P_OC = P_QC + (size_t)TOK * CAW * 2;
constexpr size_t P_OF = (size_t)TOK * ODD_IN * 2;
static_assert(P_SCR + (size_t)256 * 131072 <= SZ_P && P_OF + SZ_OB <= SZ_P, "P layout");

struct Params {
    const float* in[39];
    float* out;
    unsigned char* ws;
};
typedef const Params __attribute__((address_space(4)))* PPtr;
DI PPtr fresh_params() { PPtr q = (PPtr)__builtin_amdgcn_kernarg_segment_ptr(); asm volatile("" : "+s"(q)); return q; }
enum { I_X = 0, I_MEM, I_NMIX, I_NMQ, I_NMKV, I_NFFN, I_EVWIN, I_EVWOUT, I_HYCW, I_HYCB, I_FW1, I_FB1, I_FW2, I_FB2, I_FW3, I_FB3, I_FW4,
       I_SINF, I_HYBIAS, I_DFQG, I_DFKG, I_LQ1, I_LK1, I_LQ2, I_LK2, I_SUBLN, I_ODWIN, I_ODWOUT, I_LBLOG, I_HGNG, I_GQQG, I_GQKG,
       I_CAWQ, I_CAWKV, I_CAWO, I_CAQG, I_CAKG, I_W1, I_W2 };

DI unsigned cvt_pk_bf16(float lo, float hi) { unsigned r; asm volatile("v_cvt_pk_bf16_f32 %0, %1, %2" : "=v"(r) : "v"(lo), "v"(hi)); return r; }
DI bf16_t f2bf(float x) { return (bf16_t)(cvt_pk_bf16(x, 0.f) & 0xffffu); }
DI bf16_t f2bf_c(float x) { unsigned u = __float_as_uint(x); u += 0x7fffu + ((u >> 16) & 1u); return (bf16_t)(u >> 16); }
DI float bf2f(bf16_t b) { return __uint_as_float(((unsigned)b) << 16); }
DI float bflo(unsigned u) { return __uint_as_float(u << 16); }
DI float bfhi(unsigned u) { return __uint_as_float(u & 0xffff0000u); }
DI int otid() { int t = threadIdx.x; asm volatile("" : "+v"(t)); return t; }
template <class T> DI const T* launder(const T* p) { asm volatile("" : "+s"(p)); return p; }
DI float wave_sum(float v) {
#pragma unroll
    for (int o = 32; o > 0; o >>= 1) v += __shfl_xor(v, o);
    return v;
}

namespace pg8 {
constexpr int BM = 256, BK = 64, HALF = 128, HTB = HALF * BK * 2, STAGE_BYTES = 8 * HTB, NXCD = 8, WGM = 8;
DI int lds_byte(int r, int c) { const int st = (r >> 4) * 2 + (c >> 5), rr = r & 15, cc = c & 31, ob = rr * 64 + cc * 2; return st * 1024 + (ob ^ (((ob >> 9) & 1) << 5)); }
DI void stage_rc(int b, int& R, int& C) { const int st = b / 1024, sb = b % 1024, swz = sb ^ (((sb >> 9) & 1) << 5); R = (st >> 1) * 16 + swz / 64; C = (st & 1) * 32 + (swz % 64) / 2; }
DI int perm32(int rho) { const int n = rho >> 4, i = rho & 15; return 8 * (i >> 2) + 4 * n + (i & 3); }
struct Unit { int pm, pn; };
struct Gemm { const bf16_t* A; const bf16_t* Bt; int M, N, K; };
struct StaticOrder {
    int nM, nN, nwg, G, c, wgm;
    DI void init(int M, int N, int G_, int c_, int wgm_ = WGM) { nM = M / BM; nN = N / BM; nwg = nM * nN; G = G_; c = c_; wgm = wgm_; }
    DI bool next(int i, Unit& u) const {
        const long L = (long)i * G + c; if (L >= nwg) return false;
        int wgid = (int)L; { const int q = nwg / NXCD, r = nwg % NXCD, xcd = wgid % NXCD, off = wgid / NXCD; wgid = (xcd < r ? xcd * (q + 1) : r * (q + 1) + (xcd - r) * q) + off; }
        const int nig = wgm * nN, gid = wgid / nig, fm = gid * wgm, gsz = (nM - fm) < wgm ? (nM - fm) : wgm;
        u.pm = fm + ((wgid % nig) % gsz); u.pn = (wgid % nig) / gsz; return true;
    }
};
template <int ACT  , bool SCALE = false> struct EpiBf16 {
    static constexpr bool PERM = true;
    bf16_t* O; int ldc; const float* SSQ;
    DI void pre(const Unit& u, int wr, int fr, int fq, float (&pf)[8]) const {
        if (SCALE) { const int row0 = u.pm * BM + wr * 64 + fr;
#pragma unroll
            for (int ai = 0; ai < 2; ++ai)
#pragma unroll
                for (int m = 0; m < 4; ++m) { const f32x4* sp = (const f32x4*)(SSQ + (size_t)(row0 + ai * HALF + m * 16) * 32) + 2 * fq; const f32x4 t = sp[0] + sp[1]; pf[ai * 4 + m] = (t[0] + t[1]) + (t[2] + t[3]); } }
    }
    DI void operator()(const f32x4 (&acc)[2][2][4][2], const Unit& u, int wr, int wc, int fr, int fq, const float (&pf)[8]) const {
        const int row0 = u.pm * BM + wr * 64 + fr, col0 = u.pn * BM + wc * 32 + 8 * fq;
#pragma unroll
        for (int ai = 0; ai < 2; ++ai)
#pragma unroll
            for (int m = 0; m < 4; ++m) { bf16_t* rowp = O + (size_t)(row0 + ai * HALF + m * 16) * ldc + col0;
                float rs = 1.f;
                if (SCALE) { float ts = pf[ai * 4 + m]; ts += __shfl_xor(ts, 16); ts += __shfl_xor(ts, 32); rs = rsqrtf(ts * (1.f / DM) + EPS); }
#pragma unroll
                for (int bj = 0; bj < 2; ++bj) { f32x4 v0, v1;
                    if (SCALE) { v0 = acc[ai][bj][m][0] * rs; v1 = acc[ai][bj][m][1] * rs; }
                    else { v0 = acc[ai][bj][m][0] + (f32x4){0.f, 0.f, 0.f, 0.f}; v1 = acc[ai][bj][m][1] + (f32x4){0.f, 0.f, 0.f, 0.f}; }
                    if (ACT == 1) {
#pragma unroll
                        for (int j = 0; j < 4; ++j) { float a = fmaxf(v0[j], 0.f), b = fmaxf(v1[j], 0.f); v0[j] = a * a; v1[j] = b * b; } }
                    u32x4 w; w.x = cvt_pk_bf16(v0[0], v0[1]); w.y = cvt_pk_bf16(v0[2], v0[3]); w.z = cvt_pk_bf16(v1[0], v1[1]); w.w = cvt_pk_bf16(v1[2], v1[3]);
                    *(u32x4*)(rowp + bj * HALF) = w; } }
    }
};
struct EpiResNorm {
    static constexpr bool PERM = false;
    const float* R; float* C; bf16_t* XB; float* SSQ; int ldc;
    DI void pre(const Unit&, int, int, int, float (&)[8]) const {}
    DI void operator()(const f32x4 (&acc)[2][2][4][2], const Unit& u, int wr, int wc, int fr, int fq, const float (&)[8]) const {
        const int row0 = u.pm * BM + wr * 64 + fr, col0 = u.pn * BM + wc * 32 + 4 * fq;
        f32x4 ra[2][2][2], rb[2][2][2], rc[2][2][2];
#define EPI_LD2(DST, AI, M0) do { _Pragma("unroll") for (int mm = 0; mm < 2; ++mm) _Pragma("unroll") for (int bj = 0; bj < 2; ++bj) _Pragma("unroll") for (int n = 0; n < 2; ++n) \
        DST[mm][bj][n] = *(const f32x4*)(R + (size_t)(row0 + (AI) * HALF + ((M0) + mm) * 16) * ldc + col0 + bj * HALF + n * 16); } while (0)
#define EPI_ST2(SRC, AI, M0) do { _Pragma("unroll") for (int mm = 0; mm < 2; ++mm) { const size_t off = (size_t)(row0 + (AI) * HALF + ((M0) + mm) * 16) * ldc + col0; float ss = 0.f; \
        _Pragma("unroll") for (int bj = 0; bj < 2; ++bj) _Pragma("unroll") for (int n = 0; n < 2; ++n) { const f32x4 v = SRC[mm][bj][n] + acc[AI][bj][(M0) + mm][n]; \
            *(f32x4*)(C + off + bj * HALF + n * 16) = v; ss += v[0] * v[0] + v[1] * v[1] + v[2] * v[2] + v[3] * v[3]; \
            u32x2 w; w.x = cvt_pk_bf16(v[0], v[1]); w.y = cvt_pk_bf16(v[2], v[3]); *(u32x2*)(XB + off + bj * HALF + n * 16) = w; } \
        ss += __shfl_xor(ss, 16); ss += __shfl_xor(ss, 32); \
        if (fq == 0) SSQ[(size_t)(row0 + (AI) * HALF + ((M0) + mm) * 16) * 32 + u.pn * 4 + wc] = ss; } } while (0)
        EPI_LD2(ra, 0, 0); EPI_LD2(rb, 0, 2);
        EPI_ST2(ra, 0, 0); EPI_LD2(rc, 1, 0);
        EPI_ST2(rb, 0, 2); EPI_LD2(ra, 1, 2);
        EPI_ST2(rc, 1, 0);
        EPI_ST2(ra, 1, 2);
#undef EPI_ST2
#undef EPI_LD2
    }
};
struct EpiResF32 {
    static constexpr bool PERM = false;
    const float* R; float* C; int ldc;
    DI void pre(const Unit&, int, int, int, float (&)[8]) const {}
    DI void operator()(const f32x4 (&acc)[2][2][4][2], const Unit& u, int wr, int wc, int fr, int fq, const float (&)[8]) const {
        const int row0 = u.pm * BM + wr * 64 + fr, col0 = u.pn * BM + wc * 32 + 4 * fq;
#pragma unroll
        for (int ai = 0; ai < 2; ++ai) {
            f32x4 rv[4][2][2];
#pragma unroll
            for (int m = 0; m < 4; ++m)
#pragma unroll
                for (int bj = 0; bj < 2; ++bj)
#pragma unroll
                    for (int n = 0; n < 2; ++n) rv[m][bj][n] = *(const f32x4*)(R + (size_t)(row0 + ai * HALF + m * 16) * ldc + col0 + bj * HALF + n * 16);
#pragma unroll
            for (int m = 0; m < 4; ++m) { const size_t off = (size_t)(row0 + ai * HALF + m * 16) * ldc + col0;
#pragma unroll
                for (int bj = 0; bj < 2; ++bj)
#pragma unroll
                    for (int n = 0; n < 2; ++n) *(f32x4*)(C + off + bj * HALF + n * 16) = rv[m][bj][n] + acc[ai][bj][m][n]; }
        }
    }
};

template <class Epi, class Sched>
DI void gemm_phase(LAS unsigned char* lds, const Gemm g, const Sched& S, const Epi& E) {
    const int tid = otid(), wid = __builtin_amdgcn_readfirstlane(tid >> 6), lane = tid & 63, wr = wid >> 2, wc = wid & 3, fr = lane & 15, fq = lane >> 4;
    const int K = g.K, nt = K / BK;
    unsigned voffA[2], voffB[2];
#pragma unroll
    for (int i = 0; i < 2; ++i) { int R, C; stage_rc(tid * 16 + i * 8192, R, C); const int Rb = Epi::PERM ? ((R & ~31) + perm32(R & 31)) : R;
        voffA[i] = (unsigned)(R * K + C) * 2u; voffB[i] = (unsigned)(Rb * K + C) * 2u; }
    const size_t kstep = (size_t)(BK * 2);
    const size_t hstep = (size_t)HALF * K * 2;
    const size_t tstep = 2 * hstep;
    const unsigned ldsw = (unsigned)wid * 1024u;
    const int aoff = lds_byte(wr * 64 + fr, fq * 8), boff = lds_byte(wc * 32 + fr, fq * 8);
#define PG8_SA(b, h) (((b) * 2 + (h)) * HTB)
#define PG8_SB(b, h) ((4 + (b) * 2 + (h)) * HTB)
#define PG8_STAGE(bufoff, gbase, voff) do { _Pragma("unroll") for (int _i = 0; _i < 2; ++_i) \
        __builtin_amdgcn_global_load_lds((const unsigned*)((const char*)(gbase) + (voff)[_i]), (LAS unsigned*)(lds + (bufoff) + ldsw + _i * 8192), 16, 0, 0); } while (0)
#define PG8_LDA(dst, b, h) do { _Pragma("unroll") for (int m = 0; m < 4; ++m) _Pragma("unroll") for (int k = 0; k < 2; ++k) dst[m][k] = *(const LAS bf16x8*)(lds + PG8_SA(b, h) + aoff + m * 2048 + k * 1024); } while (0)
#define PG8_LDB(dst, b, h) do { _Pragma("unroll") for (int n = 0; n < 2; ++n) _Pragma("unroll") for (int k = 0; k < 2; ++k) dst[n][k] = *(const LAS bf16x8*)(lds + PG8_SB(b, h) + boff + n * 2048 + k * 1024); } while (0)
#define PG8_MMA(ai, bj, At, Bt) do { __builtin_amdgcn_s_setprio(1); _Pragma("unroll") for (int m = 0; m < 4; ++m) _Pragma("unroll") for (int n = 0; n < 2; ++n) _Pragma("unroll") for (int k = 0; k < 2; ++k) \
        acc[ai][bj][m][n] = __builtin_amdgcn_mfma_f32_16x16x32_bf16(Bt[n][k], At[m][k], acc[ai][bj][m][n], 0, 0, 0); __builtin_amdgcn_s_setprio(0); } while (0)
#define PG8_WAIT_V(n) asm volatile("s_waitcnt vmcnt(" #n ")" ::: "memory")
#define PG8_WAIT_L(n) asm volatile("s_waitcnt lgkmcnt(" #n ")" ::: "memory")
#define PG8_BAR __builtin_amdgcn_s_barrier()
#define PG8_SCHED __builtin_amdgcn_sched_barrier(0)
    Unit cur, nxt; int ui = 0;
    if (!S.next(0, cur)) return;
    f32x4 acc[2][2][4][2];
#pragma unroll
    for (int a = 0; a < 2; ++a)
#pragma unroll
        for (int b = 0; b < 2; ++b)
#pragma unroll
            for (int m = 0; m < 4; ++m)
#pragma unroll
                for (int n = 0; n < 2; ++n) acc[a][b][m][n] = (f32x4){0.f, 0.f, 0.f, 0.f};
    bf16x8 At[4][2], B0[2][2], B1[2][2];
    const char* cA = (const char*)g.A + (size_t)cur.pm * tstep; const char* cB = (const char*)g.Bt + (size_t)cur.pn * tstep;
    float pf[8] = {0.f, 0.f, 0.f, 0.f, 0.f, 0.f, 0.f, 0.f};
    E.pre(cur, wr, fr, fq, pf);
    PG8_STAGE(PG8_SB(0, 0), cB, voffB); PG8_STAGE(PG8_SA(0, 0), cA, voffA); PG8_STAGE(PG8_SB(0, 1), cB + hstep, voffB); PG8_STAGE(PG8_SA(0, 1), cA + hstep, voffA);
    if (wr == 1) PG8_BAR;
    PG8_WAIT_V(4); PG8_BAR;
    PG8_STAGE(PG8_SB(1, 0), cB + kstep, voffB); PG8_STAGE(PG8_SA(1, 0), cA + kstep, voffA); PG8_STAGE(PG8_SB(1, 1), cB + hstep + kstep, voffB);
    PG8_WAIT_V(6); PG8_BAR;
    for (;;) {
        const bool has_next = S.next(ui + 1, nxt);
        const char* nA = has_next ? (const char*)g.A + (size_t)nxt.pm * tstep : cA; const char* nB = has_next ? (const char*)g.Bt + (size_t)nxt.pn * tstep : cB;
        for (int t = 0; t < nt; t += 2) {
            const bool last = (t == nt - 2);
            const char* a1 = cA + (size_t)(t + 1) * kstep;
            const char* a2 = last ? nA : cA + (size_t)(t + 2) * kstep; const char* b2 = last ? nB : cB + (size_t)(t + 2) * kstep;
            const char* a3 = a2 + kstep; const char* b3 = b2 + kstep;
            PG8_LDB(B0, 0, 0); PG8_SCHED; PG8_LDA(At, 0, 0); PG8_STAGE(PG8_SA(1, 1), a1 + hstep, voffA);
            PG8_WAIT_L(8); PG8_BAR; PG8_WAIT_L(0); PG8_MMA(0, 0, At, B0); PG8_BAR; PG8_SCHED;
            PG8_LDB(B1, 0, 1); PG8_STAGE(PG8_SB(0, 0), b2, voffB);
            PG8_BAR; PG8_WAIT_L(0); PG8_MMA(0, 1, At, B1); PG8_BAR;
            PG8_LDA(At, 0, 1); PG8_STAGE(PG8_SA(0, 0), a2, voffA);
            PG8_BAR; PG8_WAIT_L(0); PG8_MMA(1, 0, At, B0); PG8_BAR; PG8_SCHED;
            PG8_STAGE(PG8_SB(0, 1), b2 + hstep, voffB);
            PG8_WAIT_V(6); PG8_BAR; PG8_MMA(1, 1, At, B1); PG8_BAR;
            PG8_LDB(B0, 1, 0); PG8_SCHED; PG8_LDA(At, 1, 0); PG8_STAGE(PG8_SA(0, 1), a2 + hstep, voffA);
            PG8_WAIT_L(8); PG8_BAR; PG8_WAIT_L(0); PG8_MMA(0, 0, At, B0); PG8_BAR; PG8_SCHED;
            PG8_LDB(B1, 1, 1); PG8_STAGE(PG8_SB(1, 0), b3, voffB);
            PG8_BAR; PG8_WAIT_L(0); PG8_MMA(0, 1, At, B1); PG8_BAR;
            PG8_LDA(At, 1, 1); PG8_STAGE(PG8_SA(1, 0), a3, voffA);
            PG8_BAR; PG8_WAIT_L(0); PG8_MMA(1, 0, At, B0); PG8_BAR; PG8_SCHED;
            PG8_STAGE(PG8_SB(1, 1), b3 + hstep, voffB);
            PG8_WAIT_V(6); PG8_BAR; PG8_MMA(1, 1, At, B1); PG8_BAR;
        }
        E(acc, cur, wr, wc, fr, fq, pf);
        if (!has_next) break;
#pragma unroll
        for (int a = 0; a < 2; ++a)
#pragma unroll
            for (int b = 0; b < 2; ++b)
#pragma unroll
                for (int m = 0; m < 4; ++m)
#pragma unroll
                    for (int n = 0; n < 2; ++n) acc[a][b][m][n] = (f32x4){0.f, 0.f, 0.f, 0.f};
        cur = nxt; cA = nA; cB = nB; ++ui;
        E.pre(cur, wr, fr, fq, pf);
    }
    PG8_WAIT_V(0);
    if (wr == 0) PG8_BAR;
    PG8_BAR;
#undef PG8_SA
#undef PG8_SB
#undef PG8_STAGE
#undef PG8_LDA
#undef PG8_LDB
#undef PG8_MMA
#undef PG8_WAIT_V
#undef PG8_WAIT_L
#undef PG8_BAR
#undef PG8_SCHED
}
}

template <class Epi>
DI void run_gemm(unsigned char* lds, const bf16_t* A, const bf16_t* Bt, int M, int N, int K, const Epi& E, int rot, int wgm = pg8::WGM) {
    pg8::Gemm g{A, Bt, M, N, K}; pg8::StaticOrder S; S.init(M, N, (int)gridDim.x, (int)((blockIdx.x + rot) % gridDim.x), wgm);
    pg8::gemm_phase<Epi, pg8::StaticOrder>((LAS unsigned char*)lds, g, S, E);
    __syncthreads();
}

#define SBAR() __builtin_amdgcn_sched_barrier(0)
DI int crow(int r, int hi) { return (r & 3) + 8 * (r >> 2) + 4 * hi; }
template <int DQK> struct KL;
template <> struct KL<128> { DI static int off(int row, int colB) { return row * 256 + (colB ^ ((row & 7) << 4)); } };
template <> struct KL<64> { DI static int off(int row, int colB) { return row * 144 + colB; } };
constexpr int ATT_SHM_V = 64 * 128 * 2, ATT_SHM_K = 64 * 128 * 2;
constexpr float ATT_THR2 = 8.f * LOG2E;

template <bool ALIBI>
DI void partialSM(f32x16& p0, f32x16& p1, float& m_reg, float& alpha, float C, float slope2, int dbh  ) {
    float pmax;
    if (ALIBI) {
        const float df = (float)dbh * slope2, s1 = slope2, s2 = 2.f * slope2, s3 = 3.f * slope2, s8 = 8.f * slope2;
#pragma unroll
        for (int q = 0; q < 4; ++q) { const float d0 = df - (float)q * s8, d1 = df - (float)(q + 4) * s8;
            p0[4 * q + 0] = fmaf(p0[4 * q + 0], C, -fabsf(d0));      p1[4 * q + 0] = fmaf(p1[4 * q + 0], C, -fabsf(d1));
            p0[4 * q + 1] = fmaf(p0[4 * q + 1], C, -fabsf(d0 - s1)); p1[4 * q + 1] = fmaf(p1[4 * q + 1], C, -fabsf(d1 - s1));
            p0[4 * q + 2] = fmaf(p0[4 * q + 2], C, -fabsf(d0 - s2)); p1[4 * q + 2] = fmaf(p1[4 * q + 2], C, -fabsf(d1 - s2));
            p0[4 * q + 3] = fmaf(p0[4 * q + 3], C, -fabsf(d0 - s3)); p1[4 * q + 3] = fmaf(p1[4 * q + 3], C, -fabsf(d1 - s3)); }
        pmax = p0[0];
#pragma unroll
        for (int r = 1; r < 16; ++r) pmax = fmaxf(pmax, p0[r]);
#pragma unroll
        for (int r = 0; r < 16; ++r) pmax = fmaxf(pmax, p1[r]);
    } else {
        pmax = p0[0];
#pragma unroll
        for (int r = 1; r < 16; ++r) pmax = fmaxf(pmax, p0[r]);
#pragma unroll
        for (int r = 0; r < 16; ++r) pmax = fmaxf(pmax, p1[r]);
        pmax *= C;
    }
    { auto rr = __builtin_amdgcn_permlane32_swap(__float_as_uint(pmax), __float_as_uint(pmax), false, false);
      pmax = fmaxf(__uint_as_float(rr[0]), __uint_as_float(rr[1])); }
    if (ALIBI) {
        if (__builtin_expect(__all(pmax <= ATT_THR2), 1)) { alpha = 1.f; }
        else { const float d = fmaxf(pmax, 0.f); alpha = __builtin_amdgcn_exp2f(-d); m_reg += d;
#pragma unroll
            for (int r = 0; r < 16; ++r) { p0[r] -= d; p1[r] -= d; } }
    } else {
        float mn;
        if (__builtin_expect(__all(pmax - m_reg <= ATT_THR2), 1)) { mn = m_reg; alpha = 1.f; }
        else { mn = fmaxf(m_reg, pmax); alpha = __builtin_amdgcn_exp2f(m_reg - mn); m_reg = mn; }
#pragma unroll
        for (int r = 0; r < 16; ++r) { p0[r] = fmaf(p0[r], C, -mn); p1[r] = fmaf(p1[r], C, -mn); }
    }
#pragma unroll
    for (int r = 0; r < 16; ++r) p0[r] = __builtin_amdgcn_exp2f(p0[r]);
}
DI void finishSM(f32x16& p0, f32x16& p1, float alpha, float& l_reg, bf16x8& pa0, bf16x8& pa1, bf16x8& pa2, bf16x8& pa3) {
#pragma unroll
    for (int r = 0; r < 16; ++r) p1[r] = __builtin_amdgcn_exp2f(p1[r]);
    float ps = 0;
#pragma unroll
    for (int r = 0; r < 16; ++r) ps += p0[r];
#pragma unroll
    for (int r = 0; r < 16; ++r) ps += p1[r];
    { auto rr = __builtin_amdgcn_permlane32_swap(__float_as_uint(ps), __float_as_uint(ps), false, false);
      ps = __uint_as_float(rr[0]) + __uint_as_float(rr[1]); }
    l_reg = l_reg * alpha + ps;
#define PK4(P, BASE, OUT) do { unsigned a0 = cvt_pk_bf16(P[BASE + 0], P[BASE + 1]), a1 = cvt_pk_bf16(P[BASE + 2], P[BASE + 3]);   \
    unsigned b0 = cvt_pk_bf16(P[BASE + 4], P[BASE + 5]), b1 = cvt_pk_bf16(P[BASE + 6], P[BASE + 7]);                              \
    auto r0 = __builtin_amdgcn_permlane32_swap(a0, b0, false, false); auto r1 = __builtin_amdgcn_permlane32_swap(a1, b1, false, false); \
    u32x4 w = {r0[0], r1[0], r0[1], r1[1]}; OUT = *reinterpret_cast<bf16x8*>(&w); } while (0)
    PK4(p0, 0, pa0); PK4(p0, 8, pa1); PK4(p1, 0, pa2); PK4(p1, 8, pa3);
#undef PK4
}
template <int DQK>
DI void qkt(f32x16& p0, f32x16& p1, const char* Ks, const bf16x8* qr, int r32, int hi, float init) {
#pragma unroll
    for (int i = 0; i < 16; ++i) { p0[i] = init; p1[i] = init; }
    __builtin_amdgcn_s_setprio(1);
#pragma unroll
    for (int d0 = 0; d0 < DQK / 16; ++d0) { const int cb = (d0 * 16 + hi * 8) * 2;
        bf16x8 b0 = *reinterpret_cast<const bf16x8*>(Ks + KL<DQK>::off(r32, cb));
        bf16x8 b1 = *reinterpret_cast<const bf16x8*>(Ks + KL<DQK>::off(32 + r32, cb));
        p0 = __builtin_amdgcn_mfma_f32_32x32x16_bf16(b0, qr[d0], p0, 0, 0, 0);
        p1 = __builtin_amdgcn_mfma_f32_32x32x16_bf16(b1, qr[d0], p1, 0, 0, 0); }
    __builtin_amdgcn_s_setprio(0);
}
DI int v_st(int k, int c) { const int kk = (k & ~0xC) | ((k & 4) << 1) | ((k & 8) >> 1); return ((kk >> 3) * 4 + (c >> 5)) * 512 + ((kk & 7) * 32 + (c & 31)) * 2; }
DI int v_rd_base(int lane) { return ((lane & 3) << 3) | (((lane >> 2) & 3) << 6) | (((lane >> 4) & 1) << 5) | (((lane >> 5) & 1) << 8); }
constexpr int v_rd_off(int d0, int ks, int half) { return d0 * 512 + ks * 4096 + half * 2048; }
template <int OFF> DI s16x4 tr_read(int vb) {
    s16x4 r; asm volatile("ds_read_b64_tr_b16 %0, %1 offset:%2" : "=&v"(r) : "v"(vb), "i"(OFF) : "memory"); return r;
}
template <int D0> DI void pv_one(f32x16& od, int vb, bf16x8 pa0, bf16x8 pa1, bf16x8 pa2, bf16x8 pa3) {
    const s16x4 l0 = tr_read<v_rd_off(D0, 0, 0)>(vb), h0 = tr_read<v_rd_off(D0, 0, 1)>(vb), l1 = tr_read<v_rd_off(D0, 1, 0)>(vb), h1 = tr_read<v_rd_off(D0, 1, 1)>(vb);
    const s16x4 l2 = tr_read<v_rd_off(D0, 2, 0)>(vb), h2 = tr_read<v_rd_off(D0, 2, 1)>(vb), l3 = tr_read<v_rd_off(D0, 3, 0)>(vb), h3 = tr_read<v_rd_off(D0, 3, 1)>(vb);
    asm volatile("s_waitcnt lgkmcnt(0)" ::: "memory"); SBAR();
#define PKV(L, H) (bf16x8){L[0], L[1], L[2], L[3], H[0], H[1], H[2], H[3]}
    __builtin_amdgcn_s_setprio(1);
    od = __builtin_amdgcn_mfma_f32_32x32x16_bf16(pa0, PKV(l0, h0), od, 0, 0, 0);
    od = __builtin_amdgcn_mfma_f32_32x32x16_bf16(pa1, PKV(l1, h1), od, 0, 0, 0);
    od = __builtin_amdgcn_mfma_f32_32x32x16_bf16(pa2, PKV(l2, h2), od, 0, 0, 0);
    od = __builtin_amdgcn_mfma_f32_32x32x16_bf16(pa3, PKV(l3, h3), od, 0, 0, 0);
    __builtin_amdgcn_s_setprio(0);
#undef PKV
}
DI void pv_d0(f32x16* o, int vb, bf16x8 pa0, bf16x8 pa1, bf16x8 pa2, bf16x8 pa3) {
    pv_one<0>(o[0], vb, pa0, pa1, pa2, pa3); pv_one<1>(o[1], vb, pa0, pa1, pa2, pa3); pv_one<2>(o[2], vb, pa0, pa1, pa2, pa3); pv_one<3>(o[3], vb, pa0, pa1, pa2, pa3);
}

template <int DQK, bool ALIBI, bool QNORM>
DI void attn_core(const bf16_t* __restrict__ Qb, int ldq, const bf16_t* __restrict__ Kh, int ldk, const bf16_t* __restrict__ Vh, int ldv,
                  int seq, char* lds, float C, float slope2, int qpos0, const float* __restrict__ qg, f32x16 (&o)[4]) {
    const int tid = otid(), wid = tid >> 6, lane = tid & 63, r32 = lane & 31, hi = lane >> 5;
    char* V_lds = lds; char* K_lds = lds + 2 * ATT_SHM_V;
    float* wsf = (float*)(lds + 2 * ATT_SHM_V + 2 * ATT_SHM_K) + wid * 64; float* li_l = wsf; float* al_l = wsf + 32;
    float m_reg = ALIBI ? 0.f : -1e30f, l_reg = 0; const float rC = 1.f / C;
#pragma unroll
    for (int d = 0; d < 4; ++d)
#pragma unroll
        for (int r = 0; r < 16; ++r) o[d][r] = 0.f;
    bf16x8 qr[DQK / 16];
    const bf16_t* Qw = Qb + (long)(wid * 32 + r32) * ldq + hi * 8;
    if (QNORM) {
        qg = launder(qg);
        float ss = 0.f;
        u32x4 raw[DQK / 16];
#pragma unroll
        for (int d0 = 0; d0 < DQK / 16; ++d0) { raw[d0] = *reinterpret_cast<const u32x4*>(Qw + d0 * 16);
#pragma unroll
            for (int e = 0; e < 4; ++e) { float a = bflo(raw[d0][e]), b = bfhi(raw[d0][e]); ss += a * a + b * b; } }
        ss += __shfl_xor(ss, 32);
        const float sc = rsqrtf(ss * (1.f / DQK) + EPS);
#pragma unroll
        for (int d0 = 0; d0 < DQK / 16; ++d0) { const float* gp = qg + d0 * 16 + hi * 8; u32x4 w;
#pragma unroll
            for (int e = 0; e < 4; ++e) w[e] = cvt_pk_bf16(bflo(raw[d0][e]) * sc * gp[2 * e], bfhi(raw[d0][e]) * sc * gp[2 * e + 1]);
            qr[d0] = *reinterpret_cast<bf16x8*>(&w); }
    } else {
#pragma unroll
        for (int d0 = 0; d0 < DQK / 16; ++d0) qr[d0] = *reinterpret_cast<const bf16x8*>(Qw + d0 * 16);
    }
    const int sr = tid >> 4, sc = (tid & 15) * 8, vst0 = v_st(sr, sc), vst1 = v_st(32 + sr, sc);
    const int kr = (DQK == 128) ? sr : (tid >> 3), kc = (DQK == 128) ? sc : (tid & 7) * 8;
    const int vb0 = (int)(uintptr_t)V_lds + v_rd_base(lane);
    bf16x8 vsA0, vsA1, ksA0, ksA1, vsB0, vsB1, ksB0, ksB1;
#define SLOAD(S, k0) do { vs##S##0 = *reinterpret_cast<const bf16x8*>(&Vh[(long)((k0) + sr) * ldv + sc]); vs##S##1 = *reinterpret_cast<const bf16x8*>(&Vh[(long)((k0) + 32 + sr) * ldv + sc]); \
    ks##S##0 = *reinterpret_cast<const bf16x8*>(&Kh[(long)((k0) + kr) * ldk + kc]); if (DQK == 128) ks##S##1 = *reinterpret_cast<const bf16x8*>(&Kh[(long)((k0) + 32 + kr) * ldk + kc]); } while (0)
#define SWRITE(b, S) do { *(bf16x8*)(V_lds + (b) * ATT_SHM_V + vst0) = vs##S##0; *(bf16x8*)(V_lds + (b) * ATT_SHM_V + vst1) = vs##S##1; \
    *(bf16x8*)(K_lds + (b) * ATT_SHM_K + KL<DQK>::off(kr, kc * 2)) = ks##S##0; if (DQK == 128) *(bf16x8*)(K_lds + (b) * ATT_SHM_K + KL<DQK>::off(32 + kr, kc * 2)) = ks##S##1; } while (0)
#define SWAIT() do { if (DQK == 128) asm volatile("s_waitcnt vmcnt(4)" ::: "memory"); else asm volatile("s_waitcnt vmcnt(3)" ::: "memory"); } while (0)
#define RESC(a) do { if (__any((a) < 1.f)) { if (hi == 0) al_l[r32] = (a); asm volatile("s_waitcnt lgkmcnt(0)" ::: "memory"); \
    _Pragma("unroll") for (int d = 0; d < 4; ++d) _Pragma("unroll") for (int r = 0; r < 16; ++r) o[d][r] *= al_l[crow(r, hi)]; } } while (0)
    f32x16 pA0, pA1, pB0, pB1; float alA, alB; bf16x8 pa0, pa1, pa2, pa3; const int NT = seq / 64;
    const int dq = qpos0 + wid * 32 + r32 - 4 * hi;
    SLOAD(A, 0); asm volatile("s_waitcnt vmcnt(0)" ::: "memory"); SWRITE(0, A); __syncthreads();
    qkt<DQK>(pA0, pA1, K_lds, qr, r32, hi, ALIBI ? -m_reg * rC : 0.f); partialSM<ALIBI>(pA0, pA1, m_reg, alA, C, slope2, dq);
    SLOAD(B, 64); if (2 < NT) SLOAD(A, 128);
    SWAIT(); SWRITE(1, B); __syncthreads();
    for (int j = 1; j + 1 < NT; j += 2) {
        SBAR(); qkt<DQK>(pB0, pB1, K_lds + ATT_SHM_K, qr, r32, hi, ALIBI ? -m_reg * rC : 0.f);
        finishSM(pA0, pA1, alA, l_reg, pa0, pa1, pa2, pa3); SBAR();
        SLOAD(B, (j + 2) * 64); SBAR();
        pv_d0(o, vb0, pa0, pa1, pa2, pa3); partialSM<ALIBI>(pB0, pB1, m_reg, alB, C, slope2, dq - j * 64);
        __syncthreads(); SWAIT(); SWRITE(0, A);
        RESC(alB); __syncthreads();
        SBAR(); qkt<DQK>(pA0, pA1, K_lds, qr, r32, hi, ALIBI ? -m_reg * rC : 0.f);
        finishSM(pB0, pB1, alB, l_reg, pa0, pa1, pa2, pa3); SBAR();
        if (j + 3 < NT) SLOAD(A, (j + 3) * 64); SBAR();
        pv_d0(o, vb0 + ATT_SHM_V, pa0, pa1, pa2, pa3); partialSM<ALIBI>(pA0, pA1, m_reg, alA, C, slope2, dq - (j + 1) * 64);
        __syncthreads(); SWAIT(); SWRITE(1, B);
        RESC(alA); __syncthreads();
    }
    SBAR(); qkt<DQK>(pB0, pB1, K_lds + ATT_SHM_K, qr, r32, hi, ALIBI ? -m_reg * rC : 0.f);
    finishSM(pA0, pA1, alA, l_reg, pa0, pa1, pa2, pa3); SBAR();
    pv_d0(o, vb0, pa0, pa1, pa2, pa3); partialSM<ALIBI>(pB0, pB1, m_reg, alB, C, slope2, dq - (NT - 1) * 64);
    __syncthreads(); RESC(alB);
    finishSM(pB0, pB1, alB, l_reg, pa0, pa1, pa2, pa3); SBAR();
    pv_d0(o, vb0 + ATT_SHM_V, pa0, pa1, pa2, pa3);
    if (hi == 0) li_l[r32] = l_reg; asm volatile("s_waitcnt lgkmcnt(0)" ::: "memory");
#pragma unroll
    for (int r = 0; r < 16; ++r) { const float rl = __builtin_amdgcn_rcpf(li_l[crow(r, hi)]);
#pragma unroll
        for (int d = 0; d < 4; ++d) o[d][r] *= rl; }
#undef SLOAD
#undef SWRITE
#undef SWAIT
#undef RESC
}
DI void store_o_bf16(const f32x16 (&o)[4], bf16_t* dst, int ld) {
    const int tid = otid(), wid = tid >> 6, lane = tid & 63, r32 = lane & 31, hi = lane >> 5;
#pragma unroll
    for (int r = 0; r < 16; ++r) { bf16_t* rp = dst + (size_t)(wid * 32 + crow(r, hi)) * ld + r32;
#pragma unroll
        for (int d = 0; d < 4; ++d) rp[d * 32] = f2bf(o[d][r]); }
}

DI void xpose_w(const float* __restrict__ W, bf16_t* __restrict__ Wt, int K, int N, float* lds, const float* __restrict__ g = nullptr) {
    const int tid = otid(), ntk = K / 64, ntn = N / 256, nt = ntk * ntn;
    for (int t = blockIdx.x; t < nt; t += gridDim.x) {
        const int tk = t / ntn, tn = t % ntn;
        f32x4 v[8];
#pragma unroll
        for (int i = 0; i < 8; ++i) { const int r = (tid >> 6) + 8 * i; v[i] = *(const f32x4*)(W + (size_t)(tk * 64 + r) * N + tn * 256 + (tid & 63) * 4); }
        if (g) {
#pragma unroll
            for (int i = 0; i < 8; ++i) v[i] *= g[tk * 64 + (tid >> 6) + 8 * i]; }
        __syncthreads();
#pragma unroll
        for (int i = 0; i < 8; ++i) { float* d = lds + ((tid >> 6) + 8 * i) * 257 + (tid & 63) * 4; d[0] = v[i][0]; d[1] = v[i][1]; d[2] = v[i][2]; d[3] = v[i][3]; }
        __syncthreads();
#pragma unroll
        for (int j = 0; j < 4; ++j) { const int id = tid + NTHR * j, n = id >> 3, k8 = (id & 7) * 8; u32x4 w;
#pragma unroll
            for (int e = 0; e < 4; ++e) w[e] = cvt_pk_bf16(lds[(k8 + 2 * e) * 257 + n], lds[(k8 + 2 * e + 1) * 257 + n]);
            *(u32x4*)(Wt + (size_t)(tn * 256 + n) * K + tk * 64 + k8) = w; }
    }
}
DI void rmsnorm_rows(const float* __restrict__ X, const float* __restrict__ g, bf16_t* __restrict__ H, int rows) {
    const int tidr = otid(); const int lane = tidr & 63, gw = blockIdx.x * 8 + (tidr >> 6), nw = gridDim.x * 8;
    for (int r = gw; r < rows; r += nw) {
        const float* xr = X + (size_t)r * DM; f32x4 v[8]; float ss = 0.f;
#pragma unroll
        for (int i = 0; i < 8; ++i) { v[i] = *(const f32x4*)(xr + i * 256 + lane * 4); ss += v[i][0] * v[i][0] + v[i][1] * v[i][1] + v[i][2] * v[i][2] + v[i][3] * v[i][3]; }
        ss = wave_sum(ss);
        const float sc = rsqrtf(ss * (1.f / DM) + EPS);
#pragma unroll
        for (int i = 0; i < 8; ++i) { const f32x4 gg = *(const f32x4*)(g + i * 256 + lane * 4);
            u32x2 w; w.x = cvt_pk_bf16(v[i][0] * sc * gg[0], v[i][1] * sc * gg[1]); w.y = cvt_pk_bf16(v[i][2] * sc * gg[2], v[i][3] * sc * gg[3]);
            *(u32x2*)(H + (size_t)r * DM + i * 256 + lane * 4) = w; }
    }
}
template <int GD>
DI void groupnorm_tile(bf16_t* __restrict__ B, int ld, int row0, int col0, const float* __restrict__ g) {
    constexpr int TPG = GD / 8, NG = 256 / GD;
    const int tid = otid();
    u32x4 raw[16];
#pragma unroll
    for (int it = 0; it < 16; ++it) { const int i = tid + NTHR * it; const int j = i % TPG, grp = (i / TPG) % NG, row = i / (TPG * NG);
        raw[it] = *(const u32x4*)(B + (size_t)(row0 + row) * ld + col0 + grp * GD + j * 8); }
#pragma unroll
    for (int it = 0; it < 16; ++it) { const int i = tid + NTHR * it; const int j = i % TPG, grp = (i / TPG) % NG, row = i / (TPG * NG);
        bf16_t* p = B + (size_t)(row0 + row) * ld + col0 + grp * GD + j * 8;
        float x[8]; float ss = 0.f;
#pragma unroll
        for (int e = 0; e < 4; ++e) { x[2 * e] = bflo(raw[it][e]); x[2 * e + 1] = bfhi(raw[it][e]); ss += x[2 * e] * x[2 * e] + x[2 * e + 1] * x[2 * e + 1]; }
#pragma unroll
        for (int o = 1; o < TPG; o <<= 1) ss += __shfl_xor(ss, o);
        const float sc = rsqrtf(ss * (1.f / GD) + EPS); u32x4 w;
#pragma unroll
        for (int e = 0; e < 4; ++e) w[e] = cvt_pk_bf16(x[2 * e] * sc * g[j * 8 + 2 * e], x[2 * e + 1] * sc * g[j * 8 + 2 * e + 1]);
        *(u32x4*)p = w;
    }
}
DI void gqa_prep_tile(bf16_t* __restrict__ P1, int row0, int col0, const float* __restrict__ g, const f32x2* __restrict__ rope) {
    const int tid = otid();
    u32x4 rawv[16];
#pragma unroll
    for (int it = 0; it < 16; ++it) { const int i = tid + NTHR * it; const int j = i & 15, hv = (i >> 4) & 1, row = i >> 5;
        rawv[it] = *(const u32x4*)(P1 + (size_t)(row0 + row) * ODD_IN + col0 + hv * 128 + j * 8); }
#pragma unroll
    for (int it = 0; it < 16; ++it) {
        const int i = tid + NTHR * it;
        const int j = i & 15, hv = (i >> 4) & 1, row = i >> 5; const int tok = row0 + row;
        bf16_t* p = P1 + (size_t)tok * ODD_IN + col0 + hv * 128 + j * 8;
        const u32x4 raw = rawv[it]; float x[8]; float ss = 0.f;
#pragma unroll
        for (int e = 0; e < 4; ++e) { x[2 * e] = bflo(raw[e]); x[2 * e + 1] = bfhi(raw[e]); ss += x[2 * e] * x[2 * e] + x[2 * e + 1] * x[2 * e + 1]; }
        ss += __shfl_xor(ss, 1); ss += __shfl_xor(ss, 2); ss += __shfl_xor(ss, 4); ss += __shfl_xor(ss, 8);
        const float sc = rsqrtf(ss * (1.f / 128) + EPS);
        const int t = tok & (SEQ - 1); const int quarter = j >> 2; const int pc = (quarter < 2) ? (t >> 6) : (t & 63);
        const f32x4* rp = (const f32x4*)(rope + pc * 32 + 8 * (j & 3));
        const f32x4 c01 = rp[0], c23 = rp[1], c45 = rp[2], c67 = rp[3];
        const float csv[8] = {c01[0], c01[2], c23[0], c23[2], c45[0], c45[2], c67[0], c67[2]};
        const float snv[8] = {c01[1], c01[3], c23[1], c23[3], c45[1], c45[3], c67[1], c67[3]};
        float y[8], out[8];
#pragma unroll
        for (int e = 0; e < 8; ++e) y[e] = x[e] * sc * g[j * 8 + e];
#pragma unroll
        for (int e = 0; e < 8; ++e) { const float partner = __shfl_xor(y[e], 4);
            out[e] = (quarter & 1) ? (y[e] * csv[e] + partner * snv[e]) : (y[e] * csv[e] - partner * snv[e]); }
        u32x4 w;
#pragma unroll
        for (int e = 0; e < 4; ++e) w[e] = cvt_pk_bf16(out[2 * e], out[2 * e + 1]);
        *(u32x4*)p = w;
    }
}
DI void hgrn_post(const bf16_t* __restrict__ OF, const bf16_t* __restrict__ OBk, const bf16_t* __restrict__ P1, const float* __restrict__ ng, bf16_t* __restrict__ HB) {
    const long total = (long)TOK * 8 * 16;
    for (long i = (long)blockIdx.x * NTHR + otid(); i < total; i += (long)gridDim.x * NTHR) {
        const int j = (int)(i & 15); const long gi = i >> 4; const int h = (int)(gi & 7); const long tok = gi >> 3;
        const size_t off = (size_t)tok * 1024 + h * 128 + j * 8;
        const u32x4 a = *(const u32x4*)(OF + off), b = *(const u32x4*)(OBk + off), gt =
 *(const u32x4*)(P1 + (size_t)tok * ODD_IN + 4096 + h * 128 + j * 8);
        float x[8], gv[8]; float ss = 0.f;
#pragma unroll
        for (int e = 0; e < 4; ++e) { x[2 * e] = bflo(a[e]) + bflo(b[e]); x[2 * e + 1] = bfhi(a[e]) + bfhi(b[e]); gv[2 * e] = bflo(gt[e]); gv[2 * e + 1] = bfhi(gt[e]);
            ss += x[2 * e] * x[2 * e] + x[2 * e + 1] * x[2 * e + 1]; }
        ss += __shfl_xor(ss, 1); ss += __shfl_xor(ss, 2); ss += __shfl_xor(ss, 4); ss += __shfl_xor(ss, 8);
        const float sc = rsqrtf(ss * (1.f / 128) + EPS); float o[8];
#pragma unroll
        for (int e = 0; e < 8; ++e) { const float s = gv[e] / (1.f + __expf(-gv[e])); o[e] = x[e] * sc * ng[j * 8 + e] * s; }
        u32x4 w;
#pragma unroll
        for (int e = 0; e < 4; ++e) w[e] = cvt_pk_bf16(o[2 * e], o[2 * e + 1]);
        *(u32x4*)(HB + (size_t)tok * DM + h * 128 + j * 8) = w;
    }
}
DI void xpose_oat(const bf16_t* __restrict__ OAT, bf16_t* __restrict__ HB, bf16_t* lds) {
    const int tid = otid();
    for (int t = blockIdx.x; t < 16 * 512; t += gridDim.x) {
        const int c0 = (t & 15) * 64, tok0 = (t >> 4) * 64;
        __syncthreads();
        { const int r = tid >> 3, ch = tid & 7; const u32x4 v = *(const u32x4*)(OAT + (size_t)(c0 + r) * TOK + tok0 + ch * 8);
          unsigned* d = (unsigned*)(lds + r * 72 + ch * 8); d[0] = v[0]; d[1] = v[1]; d[2] = v[2]; d[3] = v[3]; }
        __syncthreads();
        { const int tt = tid >> 3, cc = tid & 7; u32x4 w;
#pragma unroll
          for (int e = 0; e < 4; ++e) w[e] = (unsigned)lds[(cc * 8 + 2 * e) * 72 + tt] | ((unsigned)lds[(cc * 8 + 2 * e + 1) * 72 + tt] << 16);
          *(u32x4*)(HB + (size_t)(tok0 + tt) * DM + c0 + cc * 8) = w; }
    }
}
#define p (*pp)
DI void hyena_filters(PPtr pp, float* lds) {
    const int tid = otid(), wid = tid >> 6, lane = tid & 63;
    bf16_t* FILT = (bf16_t*)(p.ws + WS_FILT);
    const float* w1 = p.in[I_FW1]; const float* b1 = p.in[I_FB1]; const float* w2 = p.in[I_FW2]; const float* b2 = p.in[I_FB2];
    const float* w3 = p.in[I_FW3]; const float* b3 = p.in[I_FB3]; const float* w4 = p.in[I_FW4]; const float* sf = p.in[I_SINF];
    float* hb = lds + wid * 128;
    float* W1s = lds + 1024; float* W2s = W1s + 2304; float* W3s = W2s + 4096;
    __syncthreads();
    for (int i = tid; i < 528; i += NTHR) ((f32x4*)W1s)[i] = ((const f32x4*)w1)[i];
    for (int i = tid; i < 1024; i += NTHR) { ((f32x4*)W2s)[i] = ((const f32x4*)w2)[i]; ((f32x4*)W3s)[i] = ((const f32x4*)w3)[i]; }
    for (int grp = blockIdx.x; grp < SEQ / 8; grp += gridDim.x) {
        __syncthreads();
        const int pos = grp * 8 + wid;
        const float tt = (float)pos * (1.f / (SEQ - 1)), ww = (6.283185307179586f / SEQ) * (float)pos;
        float z = 0.f;
        if (lane == 0) z = tt;
        else if (lane <= 16) { const float f = 1e-4f + (float)(lane - 1) * ((15.f - 1e-4f) / 15.f); z = cosf(f * ww); }
        else if (lane <= 32) { const float f = 1e-4f + (float)(lane - 17) * ((15.f - 1e-4f) / 15.f); z = -sinf(f * ww); }
        hb[lane] = z;
        const float fr = sf[lane];
        float a = b1[lane];
#pragma unroll 11
        for (int i = 0; i < 33; ++i) a += hb[i] * W1s[i * 64 + lane];
        hb[64 + lane] = sinf(fr * a);
        a = b2[lane];
#pragma unroll 8
        for (int i = 0; i < 64; ++i) a += hb[64 + i] * W2s[i * 64 + lane];
        hb[lane] = sinf(fr * a);
        a = b3[lane];
#pragma unroll 8
        for (int i = 0; i < 64; ++i) a += hb[i] * W3s[i * 64 + lane];
        hb[64 + lane] = sinf(fr * a);
        __syncthreads();
        {
            const int c0 = 4 * tid;
            f32x4 acc[8];
#pragma unroll
            for (int q = 0; q < 8; ++q) acc[q] = (f32x4){0.f, 0.f, 0.f, 0.f};
#pragma unroll 2
            for (int i4 = 0; i4 < 64; i4 += 4) {
                f32x4 wv[4];
#pragma unroll
                for (int e = 0; e < 4; ++e) wv[e] = *(const f32x4*)(w4 + (size_t)(i4 + e) * 2048 + c0);
#pragma unroll
                for (int q = 0; q < 8; ++q) { const f32x4 hv = *(const f32x4*)(lds + q * 128 + 64 + i4);
                    acc[q] += wv[0] * hv[0] + wv[1] * hv[1] + wv[2] * hv[2] + wv[3] * hv[3]; }
            }
            const int p0 = grp * 8, cw = c0 & 1023;
            bf16_t ov[8][4];
#pragma unroll
            for (int q = 0; q < 8; ++q) { const float tq = (float)(p0 + q) * (1.f / (SEQ - 1));
#pragma unroll
                for (int e = 0; e < 4; ++e) { const float delta = -3.0701134573253945f + (float)(cw + e) * ((-15.350567286626973f + 3.0701134573253945f) / 1023.f);
                    ov[q][e] = f2bf(acc[q][e] * __expf(-tq * fabsf(delta))); } }
            if (c0 < 1024) {
#pragma unroll
                for (int e = 0; e < 4; ++e) { u32x4 w;
#pragma unroll
                    for (int k = 0; k < 4; ++k) w[k] = (unsigned)ov[7 - 2 * k][e] | ((unsigned)ov[6 - 2 * k][e] << 16);
                    *(u32x4*)(FILT + (size_t)(c0 + e) * 4096 + 2040 - p0) = w; }
            } else {
#pragma unroll
                for (int e = 0; e < 4; ++e) { bf16_t* fp = FILT + (size_t)(c0 + e - 1024) * 4096;
#pragma unroll
                    for (int q = 0; q < 8; ++q) { const int ps = p0 + q; if (ps == 0) fp[4095] = 0; else fp[2047 + ps] = ov[q][e]; } }
            }
        }
    }
}

constexpr int HY_CPY = 8224, HY_WROW = 4112, HY_WOFF = 8 * HY_CPY;
DI float conv3(float a, float b, float c, float w0, float w1, float w2, float bias) { return fmaf(a, w0, fmaf(b, w1, fmaf(c, w2, bias))); }
DI void hyena_item(PPtr pp, int c, char* lds) {
    const int tid = otid(), wid = tid >> 6, lane = tid & 63;
    const bf16_t* UT = (const bf16_t*)(p.ws + WS_P + P_UT);
    bf16_t* OAT = (bf16_t*)(p.ws + WS_P + P_OAT);
    const float* cw = p.in[I_HYCW]; const float* cb = p.in[I_HYCB];
    __syncthreads();
    {
        const bf16_t* F = (const bf16_t*)(p.ws + WS_FILT) + (size_t)c * 4096;
        const u32x4 lo = *(const u32x4*)(F + 8 * tid); u32x4 hi4 = {0u, 0u, 0u, 0u};
        if (tid < 511) hi4 = *(const u32x4*)(F + 8 * tid + 8);
        const unsigned d0 = lo[0], d1 = lo[1], d2 = lo[2], d3 = lo[3], d4 = hi4[0], d5 = hi4[1], d6 = hi4[2], d7 = hi4[3];
#define HY_AL(hi_, lo_) __builtin_amdgcn_alignbit(hi_, lo_, 16)
        *(u32x4*)(lds + 0 * HY_CPY + tid * 16) = (u32x4){d0, d1, d2, d3};
        *(u32x4*)(lds + 1 * HY_CPY + tid * 16) = (u32x4){HY_AL(d1, d0), HY_AL(d2, d1), HY_AL(d3, d2), HY_AL(d4, d3)};
        *(u32x4*)(lds + 2 * HY_CPY + tid * 16) = (u32x4){d1, d2, d3, d4};
        *(u32x4*)(lds + 3 * HY_CPY + tid * 16) = (u32x4){HY_AL(d2, d1), HY_AL(d3, d2), HY_AL(d4, d3), HY_AL(d5, d4)};
        *(u32x4*)(lds + 4 * HY_CPY + tid * 16) = (u32x4){d2, d3, d4, d5};
        *(u32x4*)(lds + 5 * HY_CPY + tid * 16) = (u32x4){HY_AL(d3, d2), HY_AL(d4, d3), HY_AL(d5, d4), HY_AL(d6, d5)};
        *(u32x4*)(lds + 6 * HY_CPY + tid * 16) = (u32x4){d3, d4, d5, d6};
        *(u32x4*)(lds + 7 * HY_CPY + tid * 16) = (u32x4){HY_AL(d4, d3), HY_AL(d5, d4), HY_AL(d6, d5), HY_AL(d7, d6)};
#undef HY_AL
    }
    {
        const int cx = 1024 + c, cv = 2048 + c;
        const float xw0 = cw[cx], xw1 = cw[3072 + cx], xw2 = cw[6144 + cx], xb = cb[cx];
        const float vw0 = cw[cv], vw1 = cw[3072 + cv], vw2 = cw[6144 + cv], vb = cb[cv];
        const bf16_t* X2 = UT + (size_t)cx * TOK; const bf16_t* V = UT + (size_t)cv * TOK;
        u32x4 xrv[8], vrv[8]; bf16_t pxv[8], nxv[8], pvv[8], nvv[8];
#pragma unroll
        for (int it = 0; it < 8; ++it) {
            const int ch = it * NTHR + tid, b = ch >> 8, s8 = (ch & 255) * 8; const size_t g0 = (size_t)b * SEQ + s8;
            const size_t gp = s8 > 0 ? g0 - 1 : g0, gn = s8 + 8 < SEQ ? g0 + 8 : g0;
            xrv[it] = *(const u32x4*)(X2 + g0); vrv[it] = *(const u32x4*)(V + g0);
            pxv[it] = X2[gp]; nxv[it] = X2[gn]; pvv[it] = V[gp]; nvv[it] = V[gn];
        }
#pragma unroll
        for (int it = 0; it < 8; ++it) {
            const int ch = it * NTHR + tid, b = ch >> 8, s8 = (ch & 255) * 8;
            const u32x4 xr = xrv[it], vr = vrv[it];
            float xe[10], ve[10];
            xe[0] = s8 > 0 ? bf2f(pxv[it]) : 0.f; ve[0] = s8 > 0 ? bf2f(pvv[it]) : 0.f;
            xe[9] = s8 + 8 < SEQ ? bf2f(nxv[it]) : 0.f; ve[9] = s8 + 8 < SEQ ? bf2f(nvv[it]) : 0.f;
#pragma unroll
            for (int e = 0; e < 4; ++e) { xe[1 + 2 * e] = bflo(xr[e]); xe[2 + 2 * e] = bfhi(xr[e]); ve[1 + 2 * e] = bflo(vr[e]); ve[2 + 2 * e] = bfhi(vr[e]); }
            float wv[8];
#pragma unroll
            for (int e = 0; e < 8; ++e) wv[e] = conv3(xe[e], xe[e + 1], xe[e + 2], xw0, xw1, xw2, xb) * conv3(ve[e], ve[e + 1], ve[e + 2], vw0, vw1, vw2, vb);
            u32x4 w;
#pragma unroll
            for (int e = 0; e < 4; ++e) w[e] = cvt_pk_bf16(wv[2 * e], wv[2 * e + 1]);
            *(u32x4*)(lds + HY_WOFF + b * HY_WROW + s8 * 2) = w;
        }
    }
    __syncthreads();
    const int m = lane & 15, kg = lane >> 4, jc = (7 - m) & 7;
    const int abase = jc * HY_CPY + (2047 - m - jc + 8 * kg) * 2;
    const int bbase = HY_WOFF + m * HY_WROW + kg * 16;
    const float x1w0 = cw[c], x1w1 = cw[3072 + c], x1w2 = cw[6144 + c], x1b = cb[c], hbias = p.in[I_HYBIAS][c];
    const bf16_t* X1 = UT + (size_t)c * TOK + (size_t)m * SEQ;
    for (int pq = 0; pq < 4; ++pq) {
        const int t00 = 64 * (wid + 8 * pq);
        f32x4 acc0 = {0.f, 0.f, 0.f, 0.f}, acc1 = acc0, acc2 = acc0, acc3 = acc0;
        const char* ap = lds + abase - 2 * t00;
        bf16x8 P2 = *(const bf16x8*)(ap - 64), P3 = *(const bf16x8*)(ap - 96);
        for (int ss = 0; ss < 64; ss += 2) {
            const int s0 = 32 * ss;
            const bf16x8 Bf = *(const bf16x8*)(lds + bbase + 2 * s0);
            const bf16x8 A0 = *(const bf16x8*)(ap + 2 * s0), A1 = *(const bf16x8*)(ap + 2 * s0 - 32);
            acc0 = __builtin_amdgcn_mfma_f32_16x16x32_bf16(A0, Bf, acc0, 0, 0, 0);
            acc1 = __builtin_amdgcn_mfma_f32_16x16x32_bf16(A1, Bf, acc1, 0, 0, 0);
            acc2 = __builtin_amdgcn_mfma_f32_16x16x32_bf16(P2, Bf, acc2, 0, 0, 0);
            acc3 = __builtin_amdgcn_mfma_f32_16x16x32_bf16(P3, Bf, acc3, 0, 0, 0);
            const bf16x8 Bg = *(const bf16x8*)(lds + bbase + 2 * s0 + 64);
            const bf16x8 Q0 = *(const bf16x8*)(ap + 2 * s0 + 64), Q1 = *(const bf16x8*)(ap + 2 * s0 + 32);
            acc0 = __builtin_amdgcn_mfma_f32_16x16x32_bf16(Q0, Bg, acc0, 0, 0, 0);
            acc1 = __builtin_amdgcn_mfma_f32_16x16x32_bf16(Q1, Bg, acc1, 0, 0, 0);
            acc2 = __builtin_amdgcn_mfma_f32_16x16x32_bf16(A0, Bg, acc2, 0, 0, 0);
            acc3 = __builtin_amdgcn_mfma_f32_16x16x32_bf16(A1, Bg, acc3, 0, 0, 0);
            P2 = Q0; P3 = Q1;
        }
#define HY_EPI(ACC, I) do { const int t = t00 + 16 * (I) + 4 * kg;                                                    \
            const u32x2 wr2 = *(const u32x2*)(lds + HY_WOFF + m * HY_WROW + t * 2);                                    \
            const u32x2 xr2 = *(const u32x2*)(X1 + t);                                                                \
            const float xm = t > 0 ? bf2f(X1[t - 1]) : 0.f, xp = t + 4 < SEQ ? bf2f(X1[t + 4]) : 0.f;                   \
            const float x0 = bflo(xr2[0]), x1 = bfhi(xr2[0]), x2 = bflo(xr2[1]), x3 = bfhi(xr2[1]);                    \
            const float o0 = (ACC[0] + bflo(wr2[0]) * hbias) * conv3(xm, x0, x1, x1w0, x1w1, x1w2, x1b);               \
            const float o1 = (ACC[1] + bfhi(wr2[0]) * hbias) * conv3(x0, x1, x2, x1w0, x1w1, x1w2, x1b);               \
            const float o2 = (ACC[2] + bflo(wr2[1]) * hbias) * conv3(x1, x2, x3, x1w0, x1w1, x1w2, x1b);               \
            const float o3 = (ACC[3] + bfhi(wr2[1]) * hbias) * conv3(x2, x3, xp, x1w0, x1w1, x1w2, x1b);               \
            u32x2 ow; ow.x = cvt_pk_bf16(o0, o1); ow.y = cvt_pk_bf16(o2, o3);                                          \
            *(u32x2*)(OAT + (size_t)c * TOK + (size_t)m * SEQ + t) = ow; } while (0)
        HY_EPI(acc0, 0); HY_EPI(acc1, 1); HY_EPI(acc2, 2); HY_EPI(acc3, 3);
#undef HY_EPI
    }
}

constexpr int HG_QE = 0, HG_KE = 17408, HG_KET = 34816, HG_VT = 53248, HG_ATT = 71680, HG_BL = 80896, HG_SEG = 81408;
DI void hgrn_item(PPtr pp, int item, char* lds) {
    const int tid = otid(), wid = tid >> 6, lane = tid & 63, m = lane & 15, kg = lane >> 4;
    const int dir = item & 1, bh = item >> 1, b = bh >> 3, h = bh & 7;
    const bf16_t* base = (const bf16_t*)(p.ws + WS_P) + (size_t)b * SEQ * ODD_IN;
    bf16_t* OD = (dir ? (bf16_t*)(p.ws + WS_OB) : (bf16_t*)(p.ws + WS_P + P_OF)) + (size_t)b * SEQ * 1024 + h * 128;
    const int kq = tid & 31, ts = tid >> 5;
    const int col_q = h * 128 + 4 * kq, col_f = 1024 * (1 + dir) + h * 128 + 4 * kq, col_v = 3072 + h * 128 + 4 * kq;
    float lb[4];
    { const float* lg = p.in[I_LBLOG] + (size_t)dir * 2 * 1024 + h * 128 + 4 * kq;
#pragma unroll
      for (int e = 0; e < 4; ++e) lb[e] = 1.f / (1.f + __expf(lg[e] - lg[1024 + e])); }
    f32x4 S[8];
#pragma unroll
    for (int i = 0; i < 8; ++i) S[i] = (f32x4){0.f, 0.f, 0.f, 0.f};
    u32x2 rq[4], rf[4], rv[4];
#define HG_LOAD(cc) do { _Pragma("unroll") for (int i = 0; i < 4; ++i) { const int t = (cc) * 64 + 4 * ts + i; const int pos = dir ? (SEQ - 1 - t) : t; \
        const bf16_t* row = base + (size_t)pos * ODD_IN; rq[i] = *(const u32x2*)(row + col_q); rf[i] = *(const u32x2*)(row + col_f); rv[i] = *(const u32x2*)(row + col_v); } } while (0)
    __syncthreads();
    HG_LOAD(0);
    float* SEG = (float*)(lds + HG_SEG); float* BL = (float*)(lds + HG_BL);
    for (int c = 0; c < 32; ++c) {
        float q[4][4], kk[4][4], cs[4][4];
#pragma unroll
        for (int i = 0; i < 4; ++i) {
            const float fz[4] = {bflo(rf[i][0]), bfhi(rf[i][0]), bflo(rf[i][1]), bfhi(rf[i][1])};
            q[i][0] = bflo(rq[i][0]); q[i][1] = bfhi(rq[i][0]); q[i][2] = bflo(rq[i][1]); q[i][3] = bfhi(rq[i][1]);
#pragma unroll
            for (int e = 0; e < 4; ++e) { const float sg = __builtin_amdgcn_rcpf(1.f + __expf(-fz[e])); const float f = lb[e] + (1.f - lb[e]) * sg;
                kk[i][e] = 1.f - f; cs[i][e] = (i == 0) ? f : cs[i - 1][e] * f; }
        }
        *(f32x4*)(SEG + ts * 128 + 4 * kq) = (f32x4){cs[3][0], cs[3][1], cs[3][2], cs[3][3]};
        const u32x2 v0 = rv[0], v1 = rv[1], v2 = rv[2], v3 = rv[3];
        __syncthreads();
        f32x4 off = {1.f, 1.f, 1.f, 1.f}, tot = {1.f, 1.f, 1.f, 1.f};
#pragma unroll
        for (int s = 0; s < 16; ++s) { const f32x4 sv = *(const f32x4*)(SEG + s * 128 + 4 * kq); tot *= sv; if (s < ts) off *= sv; }
        float ke[4][4], qe[4][4];
#pragma unroll
        for (int i = 0; i < 4; ++i)
#pragma unroll
            for (int e = 0; e < 4; ++e) { const float eb = cs[i][e] * off[e]; qe[i][e] = q[i][e] * 0.08838834764831845f * eb; ke[i][e] = kk[i][e] * __builtin_amdgcn_rcpf(eb); }
#pragma unroll
        for (int i = 0; i < 4; ++i) { const int t = 4 * ts + i;
            *(u32x2*)(lds + HG_QE + t * 272 + 8 * kq) = (u32x2){cvt_pk_bf16(qe[i][0], qe[i][1]), cvt_pk_bf16(qe[i][2], qe[i][3])};
            *(u32x2*)(lds + HG_KE + t * 272 + 8 * kq) = (u32x2){cvt_pk_bf16(ke[i][0], ke[i][1]), cvt_pk_bf16(ke[i][2], ke[i][3])}; }
#pragma unroll
        for (int e = 0; e < 4; ++e) {
            *(u32x2*)(lds + HG_KET + (4 * kq + e) * 144 + 8 * ts) = (u32x2){cvt_pk_bf16(ke[0][e], ke[1][e]), cvt_pk_bf16(ke[2][e], ke[3][e])};
            const unsigned a0 = (e & 1) ? (v0[e >> 1] >> 16) : (v0[e >> 1] & 0xffffu), a1 = (e & 1) ? (v1[e >> 1] >> 16) : (v1[e >> 1] & 0xffffu);
            const unsigned a2 = (e & 1) ? (v2[e >> 1] >> 16) : (v2[e >> 1] & 0xffffu), a3 = (e & 1) ? (v3[e >> 1] >> 16) : (v3[e >> 1] & 0xffffu);
            *(u32x2*)(lds + HG_VT + (4 * kq + e) * 144 + 8 * ts) = (u32x2){a0 | (a1 << 16), a2 | (a3 << 16)};
        }
        if (ts == 0) *(f32x4*)(BL + 4 * kq) = tot;
        if (c + 1 < 32) HG_LOAD(c + 1);
        __syncthreads();
        {
            const int ib = wid >> 1;
#pragma unroll
            for (int j2 = 0; j2 < 2; ++j2) {
                const int jb = (wid & 1) * 2 + j2;
                f32x4 a = {0.f, 0.f, 0.f, 0.f};
                if (jb <= ib) {
#pragma unroll
                    for (int k4 = 0; k4 < 4; ++k4) {
                        const bf16x8 Af = *(const bf16x8*)(lds + HG_QE + (16 * ib + m) * 272 + (32 * k4 + 8 * kg) * 2);
                        const bf16x8 Bf = *(const bf16x8*)(lds + HG_KE + (16 * jb + m) * 272 + (32 * k4 + 8 * kg) * 2);
                        a = __builtin_amdgcn_mfma_f32_16x16x32_bf16(Af, Bf, a, 0, 0, 0);
                    }
                }
                const int s = 16 * jb + m;
#pragma unroll
                for (int r = 0; r < 4; ++r) { const int t = 16 * ib + 4 * kg + r; const float v = (jb <= ib && s <= t) ? a[r] : 0.f;
                    *(bf16_t*)(lds + HG_ATT + t * 144 + s * 2) = f2bf_c(v); }
            }
        }
        __syncthreads();
        {
            bf16x8 Sb[4];
#pragma unroll
            for (int k4 = 0; k4 < 4; ++k4) { u32x4 w; w[0] = cvt_pk_bf16(S[2 * k4][0], S[2 * k4][1]); w[1] = cvt_pk_bf16(S[2 * k4][2], S[2 * k4][3]);
                w[2] = cvt_pk_bf16(S[2 * k4 + 1][0], S[2 * k4 + 1][1]); w[3] = cvt_pk_bf16(S[2 * k4 + 1][2], S[2 * k4 + 1][3]); Sb[k4] = *reinterpret_cast<bf16x8*>(&w); }
            const bf16x8 Bv0 = *(const bf16x8*)(lds + HG_VT + (16 * wid + m) * 144 + (8 * kg) * 2);
            const bf16x8 Bv1 = *(const bf16x8*)(lds + HG_VT + (16 * wid + m) * 144 + (32 + 8 * kg) * 2);
#pragma unroll
            for (int ib = 0; ib < 4; ++ib) {
                f32x4 a = {0.f, 0.f, 0.f, 0.f};
                { const bf16x8 Af = *(const bf16x8*)(lds + HG_ATT + (16 * ib + m) * 144 + (8 * kg) * 2); a = __builtin_amdgcn_mfma_f32_16x16x32_bf16(Af, Bv0, a, 0, 0, 0); }
                if (ib >= 2) { const bf16x8 Af = *(const bf16x8*)(lds + HG_ATT + (16 * ib + m) * 144 + (32 + 8 * kg) * 2); a = __builtin_amdgcn_mfma_f32_16x16x32_bf16(Af, Bv1, a, 0, 0, 0); }
#pragma unroll
                for (int k4 = 0; k4 < 4; ++k4) {
                    const u32x2 lo = *(const u32x2*)(lds + HG_QE + (16 * ib + m) * 272 + (32 * k4 + 4 * kg) * 2);
                    const u32x2 hi2 = *(const u32x2*)(lds + HG_QE + (16 * ib + m) * 272 + (32 * k4 + 16 + 4 * kg) * 2);
                    u32x4 w = {lo[0], lo[1], hi2[0], hi2[1]};
                    a = __builtin_amdgcn_mfma_f32_16x16x32_bf16(*reinterpret_cast<bf16x8*>(&w), Sb[k4], a, 0, 0, 0);
                }
#pragma unroll
                for (int r = 0; r < 4; ++r) { const int t = c * 64 + 16 * ib + 4 * kg + r; const int pos = dir ? (SEQ - 1 - t) : t;
                    OD[(size_t)pos * 1024 + 16 * wid + m] = f2bf_c(a[r]); }
            }
#pragma unroll
            for (int kb = 0; kb < 8; ++kb) {
                const bf16x8 A0 = *(const bf16x8*)(lds + HG_KET + (16 * kb + m) * 144 + (8 * kg) * 2);
                const bf16x8 A1 = *(const bf16x8*)(lds + HG_KET + (16 * kb + m) * 144 + (32 + 8 * kg) * 2);
                S[kb] = __builtin_amdgcn_mfma_f32_16x16x32_bf16(A0, Bv0, S[kb], 0, 0, 0);
                S[kb] = __builtin_amdgcn_mfma_f32_16x16x32_bf16(A1, Bv1, S[kb], 0, 0, 0);
                const f32x4 bl = *(const f32x4*)(BL + 16 * kb + 4 * kg);
                S[kb] *= bl;
            }
        }
    }
#undef HG_LOAD
}

#undef p

#define XB_TMO      128
#define XB_XCNT(j)  (256  + 64 * (j))
#define XB_XSUB(j)  (1280 + 64 * (j))
#define XB_XGEN(j)  (2304 + 64 * (j))
#define XB_TOP      3328
#define XB_TOPGEN   3392
#define XCD_BAR_WORDS 3456
#define XB_SPIN_CAP (1u << 22)
DI unsigned xb_ld(unsigned* p)              { return __hip_atomic_load(p, __ATOMIC_RELAXED, __HIP_MEMORY_SCOPE_AGENT); }
DI unsigned xb_add(unsigned* p, unsigned v) { return __hip_atomic_fetch_add(p, v, __ATOMIC_RELAXED, __HIP_MEMORY_SCOPE_AGENT); }
DI unsigned xb_xcc_id() { return (unsigned)__builtin_amdgcn_s_getreg((3 << 11) | 20) & 0xFu; }
#define XB_SPIN(cond, bar) do { unsigned _sp = 0; while (cond) { __builtin_amdgcn_s_sleep(1); \
    if ((++_sp & 255u) == 0u) { if (xb_ld(&(bar)[XB_TMO])) break; if (_sp > XB_SPIN_CAP) { atomicAdd(&(bar)[XB_TMO], 1u); break; } } } } while (0)
struct XcdBarrier { unsigned* bar; unsigned x; volatile LAS unsigned* st; };
DI XcdBarrier xcd_barrier_post(unsigned* bar, volatile LAS unsigned* st) {
    XcdBarrier b; b.bar = bar; b.x = xb_xcc_id(); b.st = st;
    if (threadIdx.x == 0) (void)xb_add(&bar[XB_XCNT(b.x)], 1u);
    return b;
}
DI void xcd_barrier_complete(unsigned* bar, unsigned x, unsigned& nloc, unsigned& nx) {
    const unsigned G = gridDim.x * gridDim.y * gridDim.z;
    unsigned sum, cnt, mine, sp = 0u;
    for (;;) {
        sum = 0u; cnt = 0u; mine = 0u;
#pragma unroll
        for (unsigned j = 0; j < 16; ++j) { const unsigned c = xb_ld(&bar[XB_XCNT(j)]); sum += c; cnt += (c > 0u) ? 1u : 0u; mine = (j == x) ? c : mine; }
        if (sum == G) break;
        __builtin_amdgcn_s_sleep(1);
        if ((++sp & 255u) == 0u) { if (xb_ld(&bar[XB_TMO])) break; if (sp > XB_SPIN_CAP) { atomicAdd(&bar[XB_TMO], 1u); break; } }
    }
    nloc = mine > 0u ? mine : 1u; nx = cnt > 0u ? cnt : 1u;
}
DI void xcd_barrier(const XcdBarrier& b) {
    asm volatile("s_waitcnt vmcnt(0)" ::: "memory");
    __syncthreads();
    if (threadIdx.x == 0) {
        unsigned* bar = b.bar;
        __builtin_amdgcn_s_waitcnt(0);
        unsigned nloc = b.st[0], nx = b.st[1];
        if (nloc == 0u) { xcd_barrier_complete(bar, b.x, nloc, nx); b.st[0] = nloc; b.st[1] = nx; }
        const unsigned old = xb_add(&bar[XB_XSUB(b.x)], 1u);
        const unsigned gen = old / nloc;
        if (old + 1u == (gen + 1u) * nloc) {
            __builtin_amdgcn_fence(__ATOMIC_RELEASE, "agent");
            asm volatile("s_waitcnt vmcnt(0)" ::: "memory");
            const unsigned og = xb_add(&bar[XB_TOP], 1u);
            const unsigned tg = og / nx;
            if (og + 1u == (tg + 1u) * nx) xb_add(&bar[XB_TOPGEN], 1u);
            else XB_SPIN(xb_ld(&bar[XB_TOPGEN]) == tg, bar);
            __builtin_amdgcn_fence(__ATOMIC_ACQUIRE, "agent");
            xb_add(&bar[XB_XGEN(b.x)], 1u);
            asm volatile("s_waitcnt vmcnt(0)" ::: "memory");
        } else {
            XB_SPIN(xb_ld(&bar[XB_XGEN(b.x)]) == gen, bar);
            __builtin_amdgcn_fence(__ATOMIC_ACQUIRE, "agent");
            asm volatile("s_waitcnt vmcnt(0)" ::: "memory");
        }
    }
    __syncthreads();
}
#define CGSYNC() do { __builtin_amdgcn_fence(__ATOMIC_RELEASE, "agent"); grid.sync(); __builtin_amdgcn_fence(__ATOMIC_ACQUIRE, "agent"); } while (0)
#define GSYNC() xcd_barrier(xb)
#define FRESH() PPtr pp = fresh_params(); unsigned char* ws = pp->ws; bf16_t* HB = (bf16_t*)(ws + WS_HB); bf16_t* PB = (bf16_t*)(ws + WS_P); float* R = pp->out; (void)HB; (void)PB; (void)R
__global__ void __launch_bounds__(NTHR) fwd_megakernel(Params p_unused) {
    extern __shared__ __attribute__((aligned(16))) unsigned char lds[];
    cg::grid_group grid = cg::this_grid();
    const int G = gridDim.x, bid = blockIdx.x;
    volatile LAS unsigned* xst = (volatile LAS unsigned*)((LAS unsigned char*)lds + (LDS_BYTES - 16));
    if (threadIdx.x == 0) { xst[0] = 0u; xst[1] = 0u; }
    __syncthreads();
    XcdBarrier xb;
    if (bid == 0) { PPtr pq = fresh_params(); unsigned* bw = (unsigned*)(pq->ws + WS_BAR);
        for (int i = otid(); i < 4096; i += NTHR) bw[i] = 0u; }

    {
        FRESH();
        xpose_w(pp->in[I_EVWIN], (bf16_t*)(ws + WS_WIN0), DM, EVEN_IN, (float*)lds);
        xpose_w(pp->in[I_ODWIN], (bf16_t*)(ws + WS_WIN1), DM, ODD_IN, (float*)lds, pp->in[I_NMIX] + DM);
        xpose_w(pp->in[I_EVWOUT], (bf16_t*)(ws + WS_WOUT), DM, DM, (float*)lds);
        xpose_w(pp->in[I_ODWOUT], (bf16_t*)(ws + WS_WOUT + SZ_WOUT), DM, DM, (float*)lds);
#pragma unroll 1
        for (int l = 0; l < 2; ++l) {
            xpose_w(pp->in[I_CAWQ] + (size_t)l * DM * CAW, (bf16_t*)(ws + WS_CAQ + l * SZ_CAQ), DM, CAW, (float*)lds, pp->in[I_NMQ] + l * DM);
            xpose_w(pp->in[I_CAWKV] + (size_t)l * DM * 2 * CAW, (bf16_t*)(ws + WS_CAKV + l * SZ_CAKV), DM, 2 * CAW, (float*)lds);
            xpose_w(pp->in[I_CAWO] + (size_t)l * CAW * DM, (bf16_t*)(ws + WS_CAO + l * SZ_CAO), CAW, DM, (float*)lds);
            xpose_w(pp->in[I_W1] + (size_t)l * DM * FFN, (bf16_t*)(ws + WS_W1 + l * SZ_W1), DM, FFN, (float*)lds, pp->in[I_NFFN] + l * DM);
            xpose_w(pp->in[I_W2] + (size_t)l * FFN * DM, (bf16_t*)(ws + WS_W2 + l * SZ_W1), FFN, DM, (float*)lds);
            rmsnorm_rows(pp->in[I_MEM], pp->in[I_NMKV] + l * DM, (bf16_t*)(ws + WS_MEMN + l * SZ_MEMN), MTOK);
        }
        { const int idx = bid * NTHR + otid();
          if (idx < 64 * 32) { const int pc = idx >> 5, ii = idx & 31; const float inv = exp2f(-(float)ii * (13.287712379549449f / 32.f));
              float sn, cs; sincosf((float)pc * inv, &sn, &cs); ((f32x2*)(ws + WS_ROPE))[idx] = (f32x2){cs, sn}; } }
        __syncthreads();
        hyena_filters(pp, (float*)lds);
        rmsnorm_rows(pp->in[I_X], pp->in[I_NMIX], HB, TOK);
    }
    CGSYNC();
    { PPtr pq = fresh_params(); xb = xcd_barrier_post((unsigned*)(pq->ws + WS_BAR), xst); }

#pragma unroll 1
    for (int layer = 0; layer < 2; ++layer) {
        if (layer == 0) {
            {
                FRESH();
                { pg8::EpiBf16<0> E{PB + P_UT / 2, TOK, nullptr}; run_gemm(lds, (const bf16_t*)(ws + WS_WIN0), HB, 3072, TOK, DM, E, 0); }
                { pg8::EpiBf16<0> E{PB + P_QKV0 / 2, 3072, nullptr}; run_gemm(lds, HB, (const bf16_t*)(ws + WS_WIN0) + (size_t)3072 * DM, TOK, 3072, DM, E, 0); }
                asm volatile("s_waitcnt vmcnt(0)" ::: "memory");
                __syncthreads();
                {
                    pg8::StaticOrder S; S.init(TOK, 3072, G, bid); pg8::Unit u;
#pragma unroll 1
                    for (int ui = 0; S.next(ui, u); ++ui)
                        if (u.pn < 8) groupnorm_tile<64>(PB + P_QKV0 / 2, 3072, u.pm * 256, u.pn * 256, u.pn < 4 ? pp->in[I_DFQG] : pp->in[I_DFKG]);
                }
#pragma unroll 1
                for (int l = 0; l < 2; ++l) { pg8::EpiBf16<0> E{(bf16_t*)(ws + WS_KV + l * SZ_KV), 1024, nullptr};
                    run_gemm(lds, (const bf16_t*)(ws + WS_MEMN + l * SZ_MEMN), (const bf16_t*)(ws + WS_CAKV + l * SZ_CAKV), MTOK, 1024, DM, E, 64 * l);
                    asm volatile("s_waitcnt vmcnt(0)" ::: "memory");
                    __syncthreads();
                    pg8::StaticOrder S; S.init(MTOK, 1024, G, (bid + 64 * l) % G); pg8::Unit u;
#pragma unroll 1
                    for (int ui = 0; S.next(ui, u); ++ui)
                        if (u.pn < 2) groupnorm_tile<128>((bf16_t*)(ws + WS_KV + l * SZ_KV), 1024, u.pm * 256, u.pn * 256, pp->in[I_CAKG] + l * 128);
                }
            }
            GSYNC();
            {
                FRESH();
#pragma unroll 1
                for (int c = bid; c < 1024; c += G) hyena_item(pp, c, (char*)lds);
            }
            {
                FRESH();
                float lam;
                { const int lane = otid() & 63; float a = pp->in[I_LQ1][lane] * pp->in[I_LK1][lane], b2 = pp->in[I_LQ2][lane] * pp->in[I_LK2][lane];
                  a = wave_sum(a); b2 = wave_sum(b2); lam = __expf(a) - __expf(b2) + 0.2f; }
                float dcut;
                { const int lane = otid() & 63; float gq = fabsf(pp->in[I_DFQG][lane]), gk = fabsf(pp->in[I_DFKG][lane]);
#pragma unroll
                  for (int o = 32; o > 0; o >>= 1) { gq = fmaxf(gq, __shfl_xor(gq, o)); gk = fmaxf(gk, __shfl_xor(gk, o)); }
                  dcut = 104.f + 2.f * (8.f * gq * gk * 1.05f) + 1.f; }
                const bf16_t* QKV = PB + P_QKV0 / 2;
                float* scr = (float*)(ws + WS_P + P_SCR) + (size_t)bid * 32768;
                unsigned* qctr = (unsigned*)(ws + WS_BAR + 15360);
                volatile LAS unsigned* qslot = (volatile LAS unsigned*)((LAS unsigned char*)lds + (LDS_BYTES - 32));
#pragma unroll 1
                for (;;) {
                    __syncthreads();
                    if (threadIdx.x == 0) *qslot = __hip_atomic_fetch_add(qctr, 1u, __ATOMIC_RELAXED, __HIP_MEMORY_SCOPE_AGENT);
                    __syncthreads();
                    const int it = (int)__builtin_amdgcn_readfirstlane(*qslot);
                    if (it >= 1024) break;
                    const int qb = it & 7, h = 7 - (it >> 7), b = (it >> 3) & 15;
                    const size_t tok0 = (size_t)b * SEQ + qb * 256;
                    const float slope = exp2f(-(float)(h + 1)), slope2 = slope * LOG2E;
                    int kt_lo, ntile;
                    { const int dk = (int)fminf(dcut / slope + 1.f, 4096.f);
                      int lo = (qb * 256 - dk) >> 6, hi = (qb * 256 + 255 + dk) >> 6; lo = lo < 0 ? 0 : lo; hi = hi > 31 ? 31 : hi;
                      if (((hi - lo + 1) & 1) != 0) { if (lo > 0) --lo; else ++hi; }
                      kt_lo = __builtin_amdgcn_readfirstlane(lo); ntile = __builtin_amdgcn_readfirstlane(hi - lo + 1); }
                    f32x16 o[4];
#pragma unroll 1
                    for (int mp = 0; mp < 2; ++mp) {
                        __syncthreads();
                        attn_core<64, true, false>(QKV + tok0 * 3072 + h * 128 + mp * 64, 3072, QKV + ((size_t)b * SEQ + kt_lo * 64) * 3072 + 1024 + h * 128 + mp * 64, 3072,
                                                   QKV + ((size_t)b * SEQ + kt_lo * 64) * 3072 + 2048 + h * 128, 3072, ntile * 64, (char*)lds, 0.125f * LOG2E, slope2, qb * 256 - kt_lo * 64, nullptr, o);
                        if (mp == 0) {
                            float* sp = scr + otid() * 64;
#pragma unroll
                            for (int d = 0; d < 4; ++d)
#pragma unroll
                                for (int r = 0; r < 16; r += 4) *(f32x4*)(sp + d * 16 + r) = (f32x4){o[d][r], o[d][r + 1], o[d][r + 2], o[d][r + 3]};
                        }
                    }
                    const int tid2 = otid(), r32 = tid2 & 31;
                    const float* subg = launder(pp->in[I_SUBLN]);
                    const float* sp = scr + tid2 * 64;
                    float ssq[16];
#pragma unroll
                    for (int r = 0; r < 16; ++r) ssq[r] = 0.f;
#pragma unroll
                    for (int d = 0; d < 4; ++d)
#pragma unroll
                        for (int r = 0; r < 16; r += 4) { const f32x4 s4 = *(const f32x4*)(sp + d * 16 + r);
#pragma unroll
                            for (int e = 0; e < 4; ++e) { const float v = s4[e] - lam * o[d][r + e]; o[d][r + e] = v; ssq[r + e] += v * v; } }
#pragma unroll
                    for (int r = 0; r < 16; ++r) {
#pragma unroll
                        for (int x = 1; x < 32; x <<= 1) ssq[r] += __shfl_xor(ssq[r], x);
                        const float sc = rsqrtf(ssq[r] * (1.f / 128) + EPS) * 0.8f;
#pragma unroll
                        for (int d = 0; d < 4; ++d) o[d][r] *= sc * subg[d * 32 + r32];
                    }
                    store_o_bf16(o, HB + tok0 * DM + 1024 + h * 128, DM);
                }
            }
            GSYNC();
            { FRESH(); xpose_oat(PB + P_OAT / 2, HB, (bf16_t*)lds); }
            GSYNC();
        } else {
            {
                FRESH();
                { pg8::EpiBf16<0, true> E{PB, ODD_IN, (const float*)(ws + WS_SSQ)}; run_gemm(lds, HB, (const bf16_t*)(ws + WS_WIN1), TOK, ODD_IN, DM, E, 0); }
                asm volatile("s_waitcnt vmcnt(0)" ::: "memory");
                __syncthreads();
                pg8::StaticOrder S; S.init(TOK, ODD_IN, G, bid); pg8::Unit u;
#pragma unroll 1
                for (int ui = 0; S.next(ui, u); ++ui)
                    if (u.pn >= 20 && u.pn < 25) gqa_prep_tile(PB, u.pm * 256, u.pn * 256, u.pn < 24 ? pp->in[I_GQQG] : pp->in[I_GQKG], (const f32x2*)(ws + WS_ROPE));
            }
            GSYNC();
            {
                FRESH();
#pragma unroll 1
                for (int it = bid; it < 256; it += G) hgrn_item(pp, it, (char*)lds);
            }
            {
                FRESH();
#pragma unroll 1
                for (int it = bid; it < 1024; it += G) {
                    const int qb = it & 7, h = (it >> 3) & 7, b = it >> 6;
                    const size_t tok0 = (size_t)b * SEQ + qb * 256;
                    f32x16 o[4];
                    __syncthreads();
                    attn_core<128, false, false>(PB + tok0 * ODD_IN + 5120 + h * 128, ODD_IN, PB + (size_t)b * SEQ * ODD_IN + 6144 + (h >> 2) * 128, ODD_IN,
                                                 PB + (size_t)b * SEQ * ODD_IN + 6400 + (h >> 2) * 128, ODD_IN, SEQ, (char*)lds, 0.08838834764831845f * LOG2E, 0.f, 0, nullptr, o);
                    store_o_bf16(o, HB + tok0 * DM + 1024 + h * 128, DM);
                }
            }
            GSYNC();
            { FRESH(); hgrn_post(PB + P_OF / 2, (const bf16_t*)(ws + WS_OB), PB, pp->in[I_HGNG], HB); }
            GSYNC();
        }
        { FRESH(); pg8::EpiResNorm E{layer == 0 ? pp->in[I_X] : R, R, PB + P_XB / 2, (float*)(ws + WS_SSQ), DM}; run_gemm(lds, HB, (const bf16_t*)(ws + WS_WOUT + layer * SZ_WOUT), TOK, DM, DM, E, 0, 4); }
        GSYNC();
        { FRESH(); pg8::EpiBf16<0, true> E{PB + P_QC / 2, CAW, (const float*)(ws + WS_SSQ)}; run_gemm(lds, PB + P_XB / 2, (const bf16_t*)(ws + WS_CAQ + layer * SZ_CAQ), TOK, CAW, DM, E, 0); }
        asm volatile("s_waitcnt vmcnt(0)" ::: "memory");
        __syncthreads();
        {
            FRESH();
            const bf16_t* KV = (const bf16_t*)(ws + WS_KV + layer * SZ_KV);
            pg8::StaticOrder S; S.init(TOK, CAW, G, bid);
            pg8::Unit u;
#pragma unroll 1
            for (int ui = 0; S.next(ui, u); ++ui) {
#pragma unroll 1
                for (int hh = 0; hh < 2; ++hh) {
                    const int h = 2 * u.pn + hh, b = u.pm >> 3;
                    const size_t tok0 = (size_t)u.pm * 256;
                    f32x16 o[4];
                    __syncthreads();
                    attn_core<128, false, true>(PB + P_QC / 2 + tok0 * CAW + h * 128, CAW, KV + (size_t)b * 256 * 1024 + h * 128, 1024,
                                                KV + (size_t)b * 256 * 1024 + 512 + h * 128, 1024, 256, (char*)lds, 0.08838834764831845f * LOG2E, 0.f, 0, pp->in[I_CAQG] + layer * 128, o);
                    store_o_bf16(o, PB + P_OC / 2 + tok0 * CAW + h * 128, CAW);
                }
            }
        }
        GSYNC();
        { FRESH(); pg8::EpiResNorm E{R, R, HB, (float*)(ws + WS_SSQ), DM}; run_gemm(lds, PB + P_OC / 2, (const bf16_t*)(ws + WS_CAO + layer * SZ_CAO), TOK, DM, CAW, E, 0, 4); }
        GSYNC();
        { FRESH(); pg8::EpiBf16<1, true> E{PB, FFN, (const float*)(ws + WS_SSQ)}; run_gemm(lds, HB, (const bf16_t*)(ws + WS_W1 + layer * SZ_W1), TOK, FFN, DM, E, 0); }
        GSYNC();
        if (layer == 0) { FRESH(); pg8::EpiResNorm E{R, R, HB, (float*)(ws + WS_SSQ), DM}; run_gemm(lds, PB, (const bf16_t*)(ws + WS_W2 + layer * SZ_W1), TOK, DM, FFN, E, 0, 4); }
        else { FRESH(); pg8::EpiResF32 E{R, R, DM}; run_gemm(lds, PB, (const bf16_t*)(ws + WS_W2 + layer * SZ_W1), TOK, DM, FFN, E, 0, 4); }
        GSYNC();
    }
}

extern "C" void kernel_launch(void* const* d_in, const int* in_sizes, int n_in, void* d_out, int out_size, void* d_ws, size_t ws_size, hipStream_t stream) {
    static int grid_blocks = 0;
    if (grid_blocks == 0) {
        if (n_in != 39 || ws_size < WS_END) { fprintf(stderr, "kernel_launch: unexpected n_in %d / ws %zu (need %zu)\n", n_in, ws_size, (size_t)WS_END); grid_blocks = -1; return; }
        int dev = 0, cus = 0, per_cu = 0;
        hipGetDevice(&dev);
        hipDeviceGetAttribute(&cus, hipDeviceAttributeMultiprocessorCount, dev);
        if (hipFuncSetAttribute((const void*)fwd_megakernel, hipFuncAttributeMaxDynamicSharedMemorySize, LDS_BYTES) != hipSuccess) { fprintf(stderr, "kernel_launch: hipFuncSetAttribute failed\n"); grid_blocks = -1; return; }
        hipOccupancyMaxActiveBlocksPerMultiprocessor(&per_cu, (const void*)fwd_megakernel, NTHR, LDS_BYTES);
        if (per_cu < 1) per_cu = 1;
        grid_blocks = cus * per_cu;
    }
    if (grid_blocks < 0) return;
    Params p{};
    for (int i = 0; i < 39; ++i) p.in[i] = (const float*)d_in[i];
    p.out = (float*)d_out; p.ws = (unsigned char*)d_ws;
    void* args[] = {&p};
    hipError_t e = hipLaunchCooperativeKernel((const void*)fwd_megakernel, dim3(grid_blocks), dim3(NTHR), args, LDS_BYTES, stream);
    if (e != hipSuccess) fprintf(stderr, "cooperative launch failed: %s (grid %d)\n", hipGetErrorString(e), grid_blocks);
}
```
